# Optimizing an MI355X kernel written in HIP

```python
import math
import jax, jax.numpy as jnp
from jax import lax
import numpy as np

D_MODEL = 1024
BATCH = 8
SEQ = 4096
DEPTH = 4

CTX_LEN = 256
GRID_W = 64
F32 = jnp.float32

GLA_HEADS = 4
GLA_DK = 64
GLA_DV = 64
GLA_GATE_RANK = 16
GLA_GATE_NORM = 16.0
GLA_CHUNK = 64
DIFF_HEADS = 4
DIFF_DH = 32
DIFF_DV = 2 * DIFF_DH
SWA_HEADS = 8
SWA_KV_HEADS = 2
SWA_Q_PER_KV = SWA_HEADS // SWA_KV_HEADS
SWA_DH = 64
WINDOW = 128
BLOCK = 128
ROPE_BASE = 10000.0

GLA_QK_W = GLA_HEADS * GLA_DK
GLA_V_W = GLA_HEADS * GLA_DV
DIFF_QK_W = DIFF_HEADS * 2 * DIFF_DH
DIFF_V_W = DIFF_HEADS * DIFF_DV
SWA_Q_W = SWA_HEADS * SWA_DH
SWA_KV_W = SWA_KV_HEADS * SWA_DH
IN_SPLITS = (GLA_QK_W, GLA_QK_W, GLA_V_W, GLA_V_W, GLA_GATE_RANK, GLA_GATE_RANK,
             DIFF_QK_W, DIFF_QK_W, DIFF_V_W, SWA_Q_W, SWA_KV_W, SWA_KV_W)
IN_WIDTH = 2 * GLA_QK_W + 2 * GLA_V_W + 2 * GLA_GATE_RANK + 2 * DIFF_QK_W + DIFF_V_W + SWA_Q_W + 2 * SWA_KV_W
MIX_WIDTH = GLA_V_W + DIFF_V_W + SWA_Q_W

FFN_HIDDEN = ((8 * D_MODEL // 3 + 255) // 256) * 256
DN_ALPHA = (2.0 * DEPTH) ** 0.25
DN_BETA = (8.0 * DEPTH) ** -0.25

kernel_name = 'hybrid_gla_diff_swa_dit_block'


def _ln_plain(x, eps=1e-6):
    xf = x.astype(F32)
    mu = jnp.mean(xf, -1, keepdims=True)
    var = jnp.mean(jnp.square(xf - mu), -1, keepdims=True)
    return (xf - mu) * lax.rsqrt(var + eps)


def layer_norm(x, g, b):
    return (_ln_plain(x) * g.astype(F32) + b.astype(F32)).astype(x.dtype)


def rms_norm(x, g, eps=1e-6):
    xf = x.astype(F32)
    y = xf * lax.rsqrt(jnp.mean(jnp.square(xf), -1, keepdims=True) + eps)
    return (y * g.astype(F32)).astype(x.dtype)


def modulate(x, shift, scale):
    return (_ln_plain(x) * (1.0 + scale.astype(F32)) + shift.astype(F32)).astype(x.dtype)


def axial_rope(rows, dim):
    row = jnp.repeat(jnp.arange(rows, dtype=F32), GRID_W)
    col = jnp.tile(jnp.arange(GRID_W, dtype=F32), rows)
    n_freq = dim // 4
    inv = jnp.power(ROPE_BASE, -jnp.arange(n_freq, dtype=F32) / n_freq)
    ang = jnp.concatenate([row[:, None] * inv, col[:, None] * inv], axis=-1)
    return jnp.cos(ang), jnp.sin(ang)


def apply_rope(x, cos, sin):
    half = x.shape[-1] // 2
    x1 = x[..., :half].astype(F32)
    x2 = x[..., half:].astype(F32)
    return jnp.concatenate([x1 * cos - x2 * sin, x1 * sin + x2 * cos], -1).astype(x.dtype)


def project_heads(p, w_gate2, b_gate2, rope_d, rope_s):
    bsz, n, _ = p.shape
    offs = [int(o) for o in np.cumsum(IN_SPLITS)[:-1]]
    g_q, g_k, g_v, g_o, g_zf, g_zb, d_q, d_k, d_v, s_q, s_k, s_v = jnp.split(p, offs, axis=-1)

    def heads(a, h):
        return jnp.moveaxis(a.reshape(bsz, n, h, -1), 2, 1)

    def gla_gate(z, w, b):
        return jax.nn.log_sigmoid((z @ w + b).astype(F32)) / GLA_GATE_NORM

    out = {
        'gq': heads(g_q, GLA_HEADS) * GLA_DK ** -0.5,
        'gk': heads(g_k, GLA_HEADS),
        'gv': heads(g_v, GLA_HEADS),
        'go': g_o,
        'gf': heads(gla_gate(g_zf, w_gate2[0], b_gate2[0]), GLA_HEADS),
        'gb': heads(gla_gate(g_zb, w_gate2[1], b_gate2[1]), GLA_HEADS),
        'dq': d_q.reshape(bsz, n, DIFF_HEADS, 2, DIFF_DH).transpose(0, 2, 3, 1, 4),
        'dk': d_k.reshape(bsz, n, DIFF_HEADS, 2, DIFF_DH).transpose(0, 2, 3, 1, 4),
        'dv': heads(d_v, DIFF_HEADS),
        'sq': s_q.reshape(bsz, n, SWA_KV_HEADS, SWA_Q_PER_KV, SWA_DH).transpose(0, 2, 3, 1, 4),
        'sk': heads(s_k, SWA_KV_HEADS),
        'sv': heads(s_v, SWA_KV_HEADS),
    }
    if rope_d is not None:
        for name in ('dq', 'dk'):
            out[name] = apply_rope(out[name], *rope_d)
        for name in ('sq', 'sk'):
            out[name] = apply_rope(out[name], *rope_s)
    return out


def gla_chunked(q, k, v, g, s0):
    bsz, nh, n, _ = q.shape
    nc = n // GLA_CHUNK

    def to_chunks(a):
        a = a.astype(F32).reshape(bsz, nh, nc, GLA_CHUNK, a.shape[-1])
        return jnp.moveaxis(a, 2, 0)

    lower = jnp.tril(jnp.ones((GLA_CHUNK, GLA_CHUNK), dtype=bool))[:, :, None]

    def step(state, inp):
        qc, kc, vc, gc = inp
        b = jnp.cumsum(gc, axis=2)
        rel = jnp.exp(jnp.where(lower, b[:, :, :, None, :] - b[:, :, None, :, :], -jnp.inf))
        att = jnp.einsum('bhtk,bhsk,bhtsk->bhts', qc, kc, rel)
        o = (jnp.einsum('bhtk,bhkv->bhtv', qc * jnp.exp(b), state)
             + jnp.einsum('bhts,bhsv->bhtv', att, vc))
        b_end = b[:, :, -1:, :]
        new_state = (jnp.exp(b_end[:, :, 0, :])[..., None] * state
                     + jnp.einsum('bhsk,bhsv->bhkv', kc * jnp.exp(b_end - b), vc))
        return new_state, o

    s_fin, o = lax.scan(step, s0.astype(F32), (to_chunks(q), to_chunks(k), to_chunks(v), to_chunks(g)))
    o = jnp.moveaxis(o, 0, 2).reshape(bsz, nh, n, -1)
    return o.astype(v.dtype), s_fin


def gla_reverse(q, k, v, g, s0):
    o, s = gla_chunked(jnp.flip(q, 2), jnp.flip(k, 2), jnp.flip(v, 2), jnp.flip(g, 2), s0)
    return jnp.flip(o, 2), s


def gla_output(o, og, g):
    bsz, nh, n, dv = o.shape
    on = rms_norm(jnp.moveaxis(o, 1, 2), g)
    return (on * jax.nn.silu(og.reshape(bsz, n, nh, dv))).reshape(bsz, n, nh * dv)


def diff_attend(q, k, v, lam):
    s = jnp.einsum('bhctd,bhcmd->bhctm', q, k).astype(F32) * (DIFF_DH ** -0.5)
    p = jax.nn.softmax(s, axis=-1)
    w = p[:, :, 0] - lam * p[:, :, 1]
    return jnp.einsum('bhtm,bhmv->bhtv', w.astype(v.dtype), v)


def diff_latent(q, k_all, v_all, lam):
    bsz, nh, _, n, dh = q.shape
    nb = n // BLOCK
    qb = jnp.moveaxis(q.reshape(bsz, nh, 2, nb, BLOCK, dh), 3, 0)
    ob = lax.map(lambda qi: diff_attend(qi, k_all, v_all, lam), qb)
    return jnp.moveaxis(ob, 0, 2).reshape(bsz, nh, n, -1)


def diff_output(o, g, lam_init):
    bsz, nh, n, dv = o.shape
    on = rms_norm(o, g) * (1.0 - lam_init)
    return jnp.moveaxis(on, 1, 2).reshape(bsz, n, nh * dv)


def swa_latent(q, k, v, kc, vc, sink):
    bsz, ng, nr, n, dh = q.shape
    nb = n // BLOCK
    n_ctx = kc.shape[2]
    scale = dh ** -0.5
    pad = ((0, 0), (0, 0), (BLOCK, BLOCK), (0, 0))
    k_pad = jnp.pad(k, pad)
    v_pad = jnp.pad(v, pad)

    def one_block(i):
        start = i * BLOCK
        qi = lax.dynamic_slice_in_dim(q, start, BLOCK, axis=3)
        ki = lax.dynamic_slice_in_dim(k_pad, start, 3 * BLOCK, axis=2)
        vi = lax.dynamic_slice_in_dim(v_pad, start, 3 * BLOCK, axis=2)
        pos_q = start + jnp.arange(BLOCK)
        pos_k = start - BLOCK + jnp.arange(3 * BLOCK)
        valid = ((jnp.abs(pos_k[None, :] - pos_q[:, None]) <= WINDOW)
                 & (pos_k >= 0)[None, :] & (pos_k < n)[None, :])
        s_loc = jnp.einsum('bgrtd,bgjd->bgrtj', qi, ki).astype(F32) * scale
        s_loc = jnp.where(valid, s_loc, -jnp.inf)
        s_ctx = jnp.einsum('bgrtd,bgmd->bgrtm', qi, kc).astype(F32) * scale
        s_snk = jnp.broadcast_to(sink.astype(F32)[None, :, :, None, None], s_ctx.shape[:-1] + (1,))
        p = jax.nn.softmax(jnp.concatenate([s_ctx, s_loc, s_snk], axis=-1), axis=-1).astype(v.dtype)
        return (jnp.einsum('bgrtm,bgmd->bgrtd', p[..., :n_ctx], vc)
                + jnp.einsum('bgrtj,bgjd->bgrtd', p[..., n_ctx:n_ctx + 3 * BLOCK], vi))

    ob = lax.map(one_block, jnp.arange(nb))
    return jnp.moveaxis(ob, 0, 3).reshape(bsz, ng, nr, n, dh)


def swa_context(q, kc, vc, sink):
    s = jnp.einsum('bgrtd,bgmd->bgrtm', q, kc).astype(F32) * (q.shape[-1] ** -0.5)
    s_snk = jnp.broadcast_to(sink.astype(F32)[None, :, :, None, None], s.shape[:-1] + (1,))
    p = jax.nn.softmax(jnp.concatenate([s, s_snk], axis=-1), axis=-1)[..., :-1].astype(vc.dtype)
    return jnp.einsum('bgrtm,bgmd->bgrtd', p, vc)


def swa_output(o):
    bsz, ng, nr, n, dh = o.shape
    return o.transpose(0, 3, 1, 2, 4).reshape(bsz, n, ng * nr * dh)


def post_norm(h, y, gate, g, b):
    return layer_norm(DN_ALPHA * h + gate * y, g, b)


def swiglu_sublayer(h, shift, scale, gate, w_g, w_u, w_d, g, b):
    u = modulate(h, shift, scale)
    f = (jax.nn.silu(u @ w_g) * (u @ w_u)) @ w_d
    return post_norm(h, f, gate, g, b)


def setup_inputs(seed: int = 0) -> dict:
    key = jax.random.key(seed)
    ks = jax.random.split(key, 20)
    D = D_MODEL

    def nrm(k, shape, s):
        return jax.random.normal(k, shape, F32) * s

    return {
        'x': nrm(ks[0], (BATCH, SEQ, D), 1.0),
        'c': nrm(ks[1], (BATCH, D), 1.0),
        'ctx': nrm(ks[2], (BATCH, CTX_LEN, D), 1.0),
        'c_ctx': nrm(ks[3], (D,), 1.0),
        'w_ada': nrm(ks[4], (DEPTH, D, 6 * D), 0.5 * D ** -0.5),
        'b_ada': nrm(ks[5], (DEPTH, 6 * D), 0.02),
        'w_in': nrm(ks[6], (DEPTH, D, IN_WIDTH), D ** -0.5),
        'w_gla_gate': nrm(ks[7], (DEPTH, 2, GLA_GATE_RANK, GLA_QK_W), GLA_GATE_RANK ** -0.5),
        'b_gla_gate': nrm(ks[8], (DEPTH, 2, GLA_QK_W), 0.1),
        'gla_norm_g': 1.0 + nrm(ks[9], (DEPTH, GLA_DV), 0.02),
        'diff_lambda': nrm(ks[10], (DEPTH, 4, DIFF_DH), 0.1),
        'diff_norm_g': 1.0 + nrm(ks[11], (DEPTH, DIFF_DV), 0.02),
        'swa_sink': nrm(ks[12], (DEPTH, SWA_HEADS), 0.5),
        'w_out': nrm(ks[13], (DEPTH, MIX_WIDTH, D), MIX_WIDTH ** -0.5 * DN_BETA),
        'ln_g': 1.0 + nrm(ks[14], (DEPTH, 2, D), 0.02),
        'ln_b': nrm(ks[15], (DEPTH, 2, D), 0.02),
        'w_ffn_gate': nrm(ks[16], (DEPTH, D, FFN_HIDDEN), D ** -0.5),
        'w_ffn_up': nrm(ks[17], (DEPTH, D, FFN_HIDDEN), D ** -0.5),
        'w_ffn_down': nrm(ks[18], (DEPTH, FFN_HIDDEN, D), FFN_HIDDEN ** -0.5 * DN_BETA),
    }


def reference(x, c, ctx, c_ctx, w_ada, b_ada, w_in, w_gla_gate, b_gla_gate, gla_norm_g,
              diff_lambda, diff_norm_g, swa_sink, w_out, ln_g, ln_b, w_ffn_gate, w_ffn_up,
              w_ffn_down):
    bsz, n_lat, _ = x.shape
    rows = n_lat // GRID_W
    rope_d = axial_rope(rows, DIFF_DH)
    rope_s = axial_rope(rows, SWA_DH)
    silu_c = jax.nn.silu(c)
    silu_cc = jax.nn.silu(c_ctx)
    h_lat, h_ctx = x, ctx
    for layer in range(DEPTH):
        last = layer == DEPTH - 1
        lam_init = 0.8 - 0.6 * math.exp(-0.3 * layer)
        m_lat = jnp.split((silu_c @ w_ada[layer] + b_ada[layer])[:, None, :], 6, axis=-1)
        m_ctx = jnp.split(silu_cc @ w_ada[layer] + b_ada[layer], 6, axis=-1)

        pl = project_heads(modulate(h_lat, m_lat[0], m_lat[1]) @ w_in[layer],
                           w_gla_gate[layer], b_gla_gate[layer], rope_d, rope_s)
        pc = project_heads(modulate(h_ctx, m_ctx[0], m_ctx[1]) @ w_in[layer],
                           w_gla_gate[layer], b_gla_gate[layer], None, None)

        zero_state = jnp.zeros((bsz, GLA_HEADS, GLA_DK, GLA_DV), F32)
        oc_f, sc_f = gla_chunked(pc['gq'], pc['gk'], pc['gv'], pc['gf'], zero_state)
        oc_b, sc_b = gla_reverse(pc['gq'], pc['gk'], pc['gv'], pc['gb'], zero_state)
        ol_f, _ = gla_chunked(pl['gq'], pl['gk'], pl['gv'], pl['gf'], sc_f)
        ol_b, _ = gla_reverse(pl['gq'], pl['gk'], pl['gv'], pl['gb'], sc_b)
        gla_lat = gla_output(ol_f + ol_b, pl['go'], gla_norm_g[layer])

        lq1 = diff_lambda[layer, 0]
        lk1 = diff_lambda[layer, 1]
        lq2 = diff_lambda[layer, 2]
        lk2 = diff_lambda[layer, 3]
        lam = (jnp.exp(jnp.sum(lq1.astype(F32) * lk1.astype(F32)))
               - jnp.exp(jnp.sum(lq2.astype(F32) * lk2.astype(F32))) + lam_init)
        dk_all = jnp.concatenate([pc['dk'], pl['dk']], axis=3)
        dv_all = jnp.concatenate([pc['dv'], pl['dv']], axis=2)
        diff_lat = diff_output(diff_latent(pl['dq'], dk_all, dv_all, lam), diff_norm_g[layer], lam_init)

        sink = swa_sink[layer].reshape(SWA_KV_HEADS, SWA_Q_PER_KV)
        swa_lat = swa_output(swa_latent(pl['sq'], pl['sk'], pl['sv'], pc['sk'], pc['sv'], sink))

        y_lat = jnp.concatenate([gla_lat, diff_lat, swa_lat], axis=-1) @ w_out[layer]
        h_lat_mid = post_norm(h_lat, y_lat, m_lat[2], ln_g[layer, 0], ln_b[layer, 0])
        h_lat_next = swiglu_sublayer(h_lat_mid, m_lat[3], m_lat[4], m_lat[5], w_ffn_gate[layer],
                                     w_ffn_up[layer], w_ffn_down[layer], ln_g[layer, 1], ln_b[layer, 1])

        if not last:
            gla_ctx = gla_output(oc_f + oc_b, pc['go'], gla_norm_g[layer])
            diff_ctx = diff_output(diff_attend(pc['dq'], pc['dk'], pc['dv'], lam), diff_norm_g[layer], lam_init)
            swa_ctx = swa_output(swa_context(pc['sq'], pc['sk'], pc['sv'], sink))
            y_ctx = jnp.concatenate([gla_ctx, diff_ctx, swa_ctx], axis=-1) @ w_out[layer]
            h_ctx_mid = post_norm(h_ctx, y_ctx, m_ctx[2], ln_g[layer, 0], ln_b[layer, 0])
            h_ctx = swiglu_sublayer(h_ctx_mid, m_ctx[3], m_ctx[4], m_ctx[5], w_ffn_gate[layer],
                                    w_ffn_up[layer], w_ffn_down[layer], ln_g[layer, 1], ln_b[layer, 1])
        h_lat = h_lat_next
    return h_lat
```

```cpp
#include <hip/hip_runtime.h>
#include <hip/hip_cooperative_groups.h>
#include <stdint.h>
#include <stdio.h>
namespace cg = cooperative_groups;

#ifndef MEGA
#define MEGA 0
#endif

typedef unsigned short bf16;
typedef __attribute__((ext_vector_type(8))) short bf16x8;
typedef __attribute__((ext_vector_type(4))) short bf16x4;
typedef __attribute__((ext_vector_type(16))) float f32x16;
typedef __attribute__((ext_vector_type(4))) float f32x4;
typedef __attribute__((ext_vector_type(4))) unsigned u32x4;
typedef __attribute__((ext_vector_type(2))) unsigned u32x2;

constexpr int DM = 1024, NBATCH = 8, SEQL = 4096, CTXL = 256, TPB = 4352, TTOK = 34816, DEPTH = 4, FFNH = 2816;
constexpr int NCHUNK = 68;
constexpr int PW = 1920;
constexpr int PC_GQ = 0, PC_GK = 256, PC_GO = 512, PC_DQ = 768, PC_DK = 1024, PC_SQ = 1280, PC_SK = 1792;
constexpr int WIN_ROWS = 2688;
constexpr float DN_ALPHA = 1.6817928305074292f;
constexpr int SMEM_BYTES = 64000;

struct Params {
  const float *x, *c, *ctx, *c_ctx, *w_ada, *b_ada, *w_in, *w_gg, *b_gg, *gla_g, *dlam, *diff_g, *sink, *w_out, *ln_g, *ln_b, *w_fg, *w_fu, *w_fd;
  float* out;
  float* Z; bf16* U; bf16* MIX; bf16* P; bf16* GVt; bf16* DVt; bf16* SVt; float* GZ; bf16* HID;
  float* SlocT; bf16* Sprev; float* DEC; float* MOD; float* ST; float* TAB32; float* TAB64; float* LAM;
  bf16 *WinT, *WoT, *WguT, *WdT;
};

__device__ __forceinline__ unsigned pk_bf16(float lo, float hi) { unsigned r; asm("v_cvt_pk_bf16_f32 %0, %1, %2" : "=v"(r) : "v"(lo), "v"(hi)); return r; }
__device__ __forceinline__ bf16 f2bf(float x) { return (bf16)(pk_bf16(x, 0.f) & 0xffffu); }
__device__ __forceinline__ float bf2f(unsigned short x) { return __uint_as_float(((unsigned)x) << 16); }
__device__ __forceinline__ float bflo(unsigned w) { return __uint_as_float(w << 16); }
__device__ __forceinline__ float bfhi(unsigned w) { return __uint_as_float(w & 0xffff0000u); }
__device__ __forceinline__ int crow(int r, int hi) { return (r & 3) + 8 * (r >> 2) + 4 * hi; }
__device__ __forceinline__ float wave_sum(float v) {
#pragma unroll
  for (int o = 32; o >= 1; o >>= 1) v += __shfl_xor(v, o);
  return v;
}
#define MFMA32(a, b, c) __builtin_amdgcn_mfma_f32_32x32x16_bf16((a), (b), (c), 0, 0, 0)

constexpr int PREP_T_PER_LAYER = 6032, PREP_T = 4 * PREP_T_PER_LAYER, PREP_MOD = 384, PREP_ITEMS = PREP_T + PREP_MOD + 1;

__device__ void transpose_tile(const float* src, int N, bf16* dst, int ldd, int n0, int k0, int drow0, char* smem) {
  float* tile = (float*)smem;
  const int tid = threadIdx.x;
#pragma unroll
  for (int i = 0; i < 8; ++i) { int k = (tid >> 5) + 8 * i, n = tid & 31; tile[k * 33 + n] = src[(size_t)(k0 + k) * N + n0 + n]; }
  __syncthreads();
  { int n = tid >> 3, kg = tid & 7; float v[8];
#pragma unroll
    for (int e = 0; e < 8; ++e) v[e] = tile[(kg * 8 + e) * 33 + n];
    u32x4 w = {pk_bf16(v[0], v[1]), pk_bf16(v[2], v[3]), pk_bf16(v[4], v[5]), pk_bf16(v[6], v[7])};
    *(u32x4*)(dst + (size_t)(drow0 + n) * ldd + k0 + kg * 8) = w; }
  __syncthreads();
}

__device__ void prep_item(const Params& p, int item, char* smem) {
  const int tid = threadIdx.x;
  if (item < PREP_T) {
    int l = item / PREP_T_PER_LAYER, ti = item % PREP_T_PER_LAYER;
    if (ti < 1296) { int nt = ti / 16, kt = ti % 16; int n0 = nt * 32; int dr = n0 < 1024 ? n0 : (n0 < 1056 ? 2560 + (n0 - 1024) : n0 - 32);
      transpose_tile(p.w_in + (size_t)l * 1024 * 2592, 2592, p.WinT + (size_t)l * WIN_ROWS * 1024, 1024, n0, kt * 64, dr, smem); }
    else if (ti < 1808) { ti -= 1296; int nt = ti / 16, kt = ti % 16;
      transpose_tile(p.w_out + (size_t)l * 1024 * 1024, 1024, p.WoT + (size_t)l * 1024 * 1024, 1024, nt * 32, kt * 64, nt * 32, smem); }
    else if (ti < 3216) { ti -= 1808; int nt = ti / 16, kt = ti % 16;
      transpose_tile(p.w_fg + (size_t)l * 1024 * FFNH, FFNH, p.WguT + (size_t)l * 5632 * 1024, 1024, nt * 32, kt * 64, nt * 64, smem); }
    else if (ti < 4624) { ti -= 3216; int nt = ti / 16, kt = ti % 16;
      transpose_tile(p.w_fu + (size_t)l * 1024 * FFNH, FFNH, p.WguT + (size_t)l * 5632 * 1024, 1024, nt * 32, kt * 64, nt * 64 + 32, smem); }
    else { ti -= 4624; int nt = ti / 44, kt = ti % 44;
      transpose_tile(p.w_fd + (size_t)l * FFNH * 1024, 1024, p.WdT + (size_t)l * 1024 * FFNH, FFNH, nt * 32, kt * 64, nt * 32, smem); }
  } else if (item < PREP_T + PREP_MOD) {
    int mi = item - PREP_T; int l = mi / 96, cb = mi % 96;
    float* sv = (float*)smem;
    float* red = sv + 9 * 1024;
    for (int idx = tid; idx < 9216; idx += 256) { int m = idx >> 10, k = idx & 1023; float v = m < 8 ? p.c[m * 1024 + k] : p.c_ctx[k]; sv[idx] = v / (1.f + expf(-v)); }
    __syncthreads();
    int kp = tid >> 6, col = tid & 63; float acc[9];
#pragma unroll
    for (int m = 0; m < 9; ++m) acc[m] = 0.f;
    const float* wp = p.w_ada + ((size_t)l * 1024 + kp * 256) * 6144 + cb * 64 + col;
#pragma unroll 4
    for (int k = 0; k < 256; ++k) { float wv = wp[(size_t)k * 6144];
#pragma unroll
      for (int m = 0; m < 9; ++m) acc[m] += sv[m * 1024 + kp * 256 + k] * wv; }
#pragma unroll
    for (int m = 0; m < 9; ++m) red[(kp * 9 + m) * 64 + col] = acc[m];
    __syncthreads();
    for (int idx = tid; idx < 576; idx += 256) { int m = idx >> 6, cc = idx & 63;
      float s = red[(0 * 9 + m) * 64 + cc] + red[(1 * 9 + m) * 64 + cc] + red[(2 * 9 + m) * 64 + cc] + red[(3 * 9 + m) * 64 + cc] + p.b_ada[l * 6144 + cb * 64 + cc];
      p.MOD[((size_t)l * 9 + m) * 6144 + cb * 64 + cc] = s; }
    __syncthreads();
  } else {
    if (tid < 64) { int pos = tid;
      for (int f = 0; f < 8; ++f) { float inv = exp2f(-(float)f / 8.f * 13.287712379549449f); float a = (float)pos * inv; p.TAB32[(pos * 8 + f) * 2] = cosf(a); p.TAB32[(pos * 8 + f) * 2 + 1] = sinf(a); }
      for (int f = 0; f < 16; ++f) { float inv = exp2f(-(float)f / 16.f * 13.287712379549449f); float a = (float)pos * inv; p.TAB64[(pos * 16 + f) * 2] = cosf(a); p.TAB64[(pos * 16 + f) * 2 + 1] = sinf(a); }
    }
    if (tid >= 64 && tid < 68) { int l = tid - 64; const float* d = p.dlam + l * 128; float s1 = 0.f, s2 = 0.f;
      for (int i = 0; i < 32; ++i) { s1 += d[i] * d[32 + i]; s2 += d[64 + i] * d[96 + i]; }
      float li = 0.8f - 0.6f * expf(-0.3f * (float)l);
      p.LAM[l * 2] = expf(s1) - expf(s2) + li; p.LAM[l * 2 + 1] = li; }
  }
}

__device__ void rowpass_item(const Params& p, int layer, int sub, int item) {
  const int w = threadIdx.x >> 6, lane = threadIdx.x & 63;
  const int row = item * 4 + w;
  const int b = row / TPB, tin = row % TPB; const bool isctx = tin < CTXL;
  const bool first = (layer == 0 && sub == 0);
  const float* src = first ? (isctx ? p.ctx + ((size_t)b * CTXL + tin) * DM : p.x + ((size_t)b * SEQL + (tin - CTXL)) * DM) : p.Z + (size_t)row * DM;
  f32x4 v[4];
#pragma unroll
  for (int i = 0; i < 4; ++i) v[i] = *(const f32x4*)(src + i * 256 + lane * 4);
  if (!first) {
    float s = 0.f;
#pragma unroll
    for (int i = 0; i < 4; ++i) s += (v[i][0] + v[i][1]) + (v[i][2] + v[i][3]);
    const float mean = wave_sum(s) * (1.f / 1024.f);
    float q = 0.f;
#pragma unroll
    for (int i = 0; i < 4; ++i) { f32x4 d = v[i] - mean; q += (d[0] * d[0] + d[1] * d[1]) + (d[2] * d[2] + d[3] * d[3]); }
    const float rstd = rsqrtf(wave_sum(q) * (1.f / 1024.f) + 1e-6f);
    if (lane == 0) { p.ST[row * 2] = mean; p.ST[row * 2 + 1] = rstd; }
    const int gl = sub == 0 ? (layer - 1) * 2 + 1 : layer * 2;
    const float* g = p.ln_g + (size_t)gl * DM; const float* bb = p.ln_b + (size_t)gl * DM;
#pragma unroll
    for (int i = 0; i < 4; ++i) { f32x4 gv = *(const f32x4*)(g + i * 256 + lane * 4), bv = *(const f32x4*)(bb + i * 256 + lane * 4); v[i] = (v[i] - mean) * rstd * gv + bv; }
  } else {
    if (lane == 0) { p.ST[row * 2] = 0.f; p.ST[row * 2 + 1] = 1.f; }
#pragma unroll
    for (int i = 0; i < 4; ++i) *(f32x4*)(p.Z + (size_t)row * DM + i * 256 + lane * 4) = v[i];
  }
  if (layer == DEPTH) {
    if (!isctx) { float* o = p.out + ((size_t)b * SEQL + (tin - CTXL)) * DM;
#pragma unroll
      for (int i = 0; i < 4; ++i) *(f32x4*)(o + i * 256 + lane * 4) = v[i]; }
    return;
  }
  float s = 0.f;
#pragma unroll
  for (int i = 0; i < 4; ++i) s += (v[i][0] + v[i][1]) + (v[i][2] + v[i][3]);
  const float mean2 = wave_sum(s) * (1.f / 1024.f);
  float q = 0.f;
#pragma unroll
  for (int i = 0; i < 4; ++i) { f32x4 d = v[i] - mean2; q += (d[0] * d[0] + d[1] * d[1]) + (d[2] * d[2] + d[3] * d[3]); }
  const float rstd2 = rsqrtf(wave_sum(q) * (1.f / 1024.f) + 1e-6f);
  const int msel = isctx ? 8 : b;
  const float* md = p.MOD + ((size_t)layer * 9 + msel) * 6144;
  const float* sh = md + (sub ? 3 : 0) * DM; const float* sc = md + (sub ? 4 : 1) * DM;
#pragma unroll
  for (int i = 0; i < 4; ++i) { f32x4 shv = *(const f32x4*)(sh + i * 256 + lane * 4), scv = *(const f32x4*)(sc + i * 256 + lane * 4);
    f32x4 u = (v[i] - mean2) * rstd2 * (scv + 1.f) + shv;
    u32x2 wv = {pk_bf16(u[0], u[1]), pk_bf16(u[2], u[3])};
    *(u32x2*)(p.U + (size_t)row * DM + i * 256 + lane * 4) = wv; }
}

constexpr int GLS = 40;
enum { G_INPROJ = 0, G_OUTPROJ = 1, G_FFNUP = 2, G_FFNDOWN = 3 };

template <int MODE>
__device__ void gemm_item(const Params& p, int layer, int item, char* smem) {
  constexpr int NTN = MODE == G_INPROJ ? 21 : (MODE == G_FFNUP ? 44 : 8);
  constexpr int K = MODE == G_FFNDOWN ? FFNH : DM;
  const int mt = item / NTN, nt = item % NTN; const int m0 = mt * 128, n0 = nt * 128;
  const bf16* A; const bf16* Bt; int lda = K, ldb = K;
  if (MODE == G_INPROJ) { A = p.U; Bt = p.WinT + (size_t)layer * WIN_ROWS * DM; }
  else if (MODE == G_OUTPROJ) { A = p.MIX; Bt = p.WoT + (size_t)layer * DM * DM; }
  else if (MODE == G_FFNUP) { A = p.U; Bt = p.WguT + (size_t)layer * 5632 * DM; }
  else { A = p.HID; Bt = p.WdT + (size_t)layer * DM * FFNH; }
  const int tid = threadIdx.x, lane = tid & 63, w = tid >> 6, wm = w >> 1, wn = w & 1, l31 = lane & 31, lh = lane >> 5;
  bf16* sA = (bf16*)smem; bf16* sB = sA + 2 * 128 * GLS;
  const int r0 = tid >> 2, kc = (tid & 3) * 8;
  const bf16* a0 = A + (size_t)(m0 + r0) * lda + kc; const bf16* a1 = a0 + (size_t)64 * lda;
  const bf16* b0 = Bt + (size_t)(n0 + r0) * ldb + kc; const bf16* b1 = b0 + (size_t)64 * ldb;
  const int so0 = r0 * GLS + kc, so1 = so0 + 64 * GLS;
  u32x4 ra0 = *(const u32x4*)a0, ra1 = *(const u32x4*)a1, rb0 = *(const u32x4*)b0, rb1 = *(const u32x4*)b1;
  *(u32x4*)(sA + so0) = ra0; *(u32x4*)(sA + so1) = ra1; *(u32x4*)(sB + so0) = rb0; *(u32x4*)(sB + so1) = rb1;
  __syncthreads();
  f32x16 acc[2][2];
#pragma unroll
  for (int i = 0; i < 2; ++i)
#pragma unroll
    for (int j = 0; j < 2; ++j)
#pragma unroll
      for (int r = 0; r < 16; ++r) acc[i][j][r] = 0.f;
  constexpr int NK = K / 32;
  for (int kt = 0; kt < NK; ++kt) {
    const int cur = kt & 1;
    if (kt + 1 < NK) { const int ko = (kt + 1) * 32; ra0 = *(const u32x4*)(a0 + ko); ra1 = *(const u32x4*)(a1 + ko); rb0 = *(const u32x4*)(b0 + ko); rb1 = *(const u32x4*)(b1 + ko); }
    const bf16* cA = sA + cur * 128 * GLS; const bf16* cB = sB + cur * 128 * GLS;
#pragma unroll
    for (int ks = 0; ks < 2; ++ks) {
      bf16x8 af[2], bfr[2];
#pragma unroll
      for (int i = 0; i < 2; ++i) af[i] = *(const bf16x8*)(cA + (wm * 64 + i * 32 + l31) * GLS + ks * 16 + lh * 8);
#pragma unroll
      for (int j = 0; j < 2; ++j) bfr[j] = *(const bf16x8*)(cB + (wn * 64 + j * 32 + l31) * GLS + ks * 16 + lh * 8);
#pragma unroll
      for (int i = 0; i < 2; ++i)
#pragma unroll
        for (int j = 0; j < 2; ++j) acc[i][j] = MFMA32(af[i], bfr[j], acc[i][j]);
    }
    if (kt + 1 < NK) { const int nb = (cur ^ 1) * 128 * GLS;
      *(u32x4*)(sA + nb + so0) = ra0; *(u32x4*)(sA + nb + so1) = ra1; *(u32x4*)(sB + nb + so0) = rb0; *(u32x4*)(sB + nb + so1) = rb1; }
    __syncthreads();
  }
  const int bidx = m0 / TPB, tin0 = m0 % TPB; const bool ctxtile = tin0 < CTXL; const int msel = ctxtile ? 8 : bidx;
  if (MODE == G_OUTPROJ || MODE == G_FFNDOWN) {
    const float* gate = p.MOD + ((size_t)layer * 9 + msel) * 6144 + (MODE == G_OUTPROJ ? 2 : 5) * DM;
    const bool haveln = !(MODE == G_OUTPROJ && layer == 0);
    const int gl = MODE == G_OUTPROJ ? (layer - 1) * 2 + 1 : layer * 2;
    const float* g = p.ln_g + (size_t)(haveln ? gl : 0) * DM; const float* bb = p.ln_b + (size_t)(haveln ? gl : 0) * DM;
#pragma unroll
    for (int j = 0; j < 2; ++j) {
      const int col = n0 + wn * 64 + j * 32 + l31;
      const float gt = gate[col]; const float gv = haveln ? g[col] : 1.f; const float bv = haveln ? bb[col] : 0.f;
#pragma unroll
      for (int i = 0; i < 2; ++i)
#pragma unroll
        for (int r = 0; r < 16; ++r) {
          const int row = m0 + wm * 64 + i * 32 + crow(r, lh);
          float* zp = p.Z + (size_t)row * DM + col;
          const float mean = p.ST[row * 2], rstd = p.ST[row * 2 + 1];
          const float h = (*zp - mean) * rstd * gv + bv;
          *zp = DN_ALPHA * h + gt * acc[i][j][r];
        }
    }
  } else if (MODE == G_FFNUP) {
    const int hcol = (n0 + wn * 64) / 2 + l31;
#pragma unroll
    for (int i = 0; i < 2; ++i)
#pragma unroll
      for (int r = 0; r < 16; ++r) {
        const int row = m0 + wm * 64 + i * 32 + crow(r, lh);
        const float gg = acc[i][0][r], uu = acc[i][1][r];
        const float hv = gg / (1.f + __expf(-gg)) * uu;
        p.HID[(size_t)row * FFNH + hcol] = f2bf(hv);
      }
  } else {
    float* sC = (float*)smem;
    int mode, dcol = 0; float scale = 1.f; bf16* xt = nullptr; int xcols = 0, xcb = 0;
    if (nt < 2) { mode = 0; scale = 0.125f; dcol = PC_GQ + nt * 128; }
    else if (nt < 4) { mode = 0; dcol = PC_GK + (nt - 2) * 128; }
    else if (nt < 6) { mode = 3; xt = p.GVt; xcols = 256; xcb = (nt - 4) * 128; }
    else if (nt < 8) { mode = 0; dcol = PC_GO + (nt - 6) * 128; }
    else if (nt < 10) { mode = 1; scale = 0.17677669529663687f; dcol = PC_DQ + (nt - 8) * 128; }
    else if (nt < 12) { mode = 1; dcol = PC_DK + (nt - 10) * 128; }
    else if (nt < 14) { mode = 3; xt = p.DVt; xcols = 256; xcb = (nt - 12) * 128; }
    else if (nt < 18) { mode = 2; scale = 0.125f; dcol = PC_SQ + (nt - 14) * 128; }
    else if (nt < 19) { mode = 2; dcol = PC_SK; }
    else if (nt < 20) { mode = 3; xt = p.SVt; xcols = 128; xcb = 0; }
    else mode = 4;
    for (int half = 0; half < 2; ++half) {
      if (wm == half) {
#pragma unroll
        for (int i = 0; i < 2; ++i)
#pragma unroll
          for (int j = 0; j < 2; ++j)
#pragma unroll
            for (int r = 0; r < 16; ++r) sC[(i * 32 + crow(r, lh)) * 133 + wn * 64 + j * 32 + l31] = acc[i][j][r];
      }
      __syncthreads();
      if (mode <= 2) {
        for (int it = tid; it < 1024; it += 256) {
          const int row = it >> 4, cg8 = (it & 15) * 8; const int tin = tin0 + half * 64 + row; const size_t token = (size_t)m0 + half * 64 + row;
          float v[8];
#pragma unroll
          for (int e = 0; e < 8; ++e) v[e] = sC[row * 133 + cg8 + e];
          if (mode != 0 && !ctxtile) {
            const int dimh = mode == 1 ? 16 : 32; const int d = cg8 & (2 * dimh - 1); const bool second = d >= dimh; const int pi0 = second ? d - dimh : d;
            const int pcol = second ? cg8 - dimh : cg8 + dimh; const int nf = dimh >> 1; const bool usecol = pi0 >= nf; const int f0 = usecol ? pi0 - nf : pi0;
            const int pos = tin - CTXL; const int ps = usecol ? (pos & 63) : (pos >> 6);
            const float* tb = (mode == 1 ? p.TAB32 + (ps * 8 + f0) * 2 : p.TAB64 + (ps * 16 + f0) * 2);
#pragma unroll
            for (int e = 0; e < 8; ++e) { const float wv = sC[row * 133 + pcol + e]; const float cs = tb[e * 2], sn = tb[e * 2 + 1];
              v[e] = second ? (wv * sn + v[e] * cs) : (v[e] * cs - wv * sn); }
          }
          u32x4 wv = {pk_bf16(v[0] * scale, v[1] * scale), pk_bf16(v[2] * scale, v[3] * scale), pk_bf16(v[4] * scale, v[5] * scale), pk_bf16(v[6] * scale, v[7] * scale)};
          *(u32x4*)(p.P + token * PW + dcol + cg8) = wv;
        }
      } else if (mode == 3) {
        for (int it = tid; it < 1024; it += 256) {
          const int col = it >> 3, g8 = it & 7; float v[8];
#pragma unroll
          for (int e = 0; e < 8; ++e) v[e] = sC[(g8 * 8 + e) * 133 + col];
          u32x4 wv = {pk_bf16(v[0], v[1]), pk_bf16(v[2], v[3]), pk_bf16(v[4], v[5]), pk_bf16(v[6], v[7])};
          *(u32x4*)(xt + ((size_t)bidx * xcols + xcb + col) * TPB + tin0 + half * 64 + g8 * 8) = wv;
        }
      } else {
        for (int it = tid; it < 512; it += 256) { const int row = it >> 3, c4 = (it & 7) * 4; const size_t token = (size_t)m0 + half * 64 + row;
          f32x4 o = {sC[row * 133 + c4], sC[row * 133 + c4 + 1], sC[row * 133 + c4 + 2], sC[row * 133 + c4 + 3]};
          *(f32x4*)(p.GZ + token * 32 + c4) = o; }
      }
      __syncthreads();
    }
  }
}

constexpr int TS = 72;
__device__ __forceinline__ f32x16 nt64(const bf16* sA, const bf16* sB, f32x16 acc) {
  const int lane = threadIdx.x & 63, w = threadIdx.x >> 6, wi = w >> 1, wj = w & 1, l31 = lane & 31, lh = lane >> 5;
#pragma unroll
  for (int ks = 0; ks < 4; ++ks) {
    bf16x8 a = *(const bf16x8*)(sA + (wi * 32 + l31) * TS + ks * 16 + lh * 8);
    bf16x8 b = *(const bf16x8*)(sB + (wj * 32 + l31) * TS + ks * 16 + lh * 8);
    acc = MFMA32(a, b, acc);
  }
  return acc;
}

__device__ void gla_cumgate(const Params& p, int layer, int h, int dir, const float* sz, float* sb, float* stot) {
  const int tid = threadIdx.x, qtr = tid >> 6, k = tid & 63;
  const float* W = p.w_gg + ((size_t)(layer * 2 + dir) * 16) * 256 + h * 64 + k;
  float wv[16];
#pragma unroll
  for (int r = 0; r < 16; ++r) wv[r] = W[r * 256];
  const float bias = p.b_gg[(layer * 2 + dir) * 256 + h * 64 + k];
  float cum = 0.f;
#pragma unroll 4
  for (int i = 0; i < 16; ++i) {
    const int t = dir == 0 ? qtr * 16 + i : qtr * 16 + 15 - i;
    float z = bias;
#pragma unroll
    for (int r = 0; r < 16; ++r) z += sz[t * 32 + dir * 16 + r] * wv[r];
    const float ls = fminf(z, 0.f) - log1pf(expf(-fabsf(z)));
    cum += ls * 0.0625f;
    sb[t * 65 + k] = cum;
  }
  stot[qtr * 64 + k] = cum;
  __syncthreads();
  float off = 0.f;
#pragma unroll
  for (int q = 0; q < 4; ++q) if (dir == 0 ? q < qtr : q > qtr) off += stot[q * 64 + k];
#pragma unroll 4
  for (int i = 0; i < 16; ++i) sb[(qtr * 16 + i) * 65 + k] += off;
  __syncthreads();
}

constexpr int L_SB = 0, L_STOT = 16640, L_T0 = 17664, L_TSZ = 64 * TS * 2  ;

__device__ void gla_load_common(const Params& p, int b, int h, int chunk, float* sz, bf16* sVt) {
  const int tid = threadIdx.x; const size_t token0 = (size_t)b * TPB + chunk * 64;
#pragma unroll
  for (int i = 0; i < 8; ++i) { int it = tid + 256 * i; sz[it] = p.GZ[token0 * 32 + it]; }
#pragma unroll
  for (int i = 0; i < 2; ++i) { int it = tid + 256 * i; int dv = it >> 3, ch = it & 7;
    *(u32x4*)(sVt + dv * TS + ch * 8) = *(const u32x4*)(p.GVt + ((size_t)b * 256 + h * 64 + dv) * TPB + chunk * 64 + ch * 8); }
}

__device__ void gla_g1_item(const Params& p, int layer, int item, char* smem) {
  const int chunk = item % NCHUNK, bh = item / NCHUNK, b = bh >> 2, h = bh & 3;
  const int tid = threadIdx.x, lane = tid & 63, w = tid >> 6, wi = w >> 1, wj = w & 1, l31 = lane & 31, lh = lane >> 5;
  float* sb = (float*)(smem + L_SB); float* stot = (float*)(smem + L_STOT);
  bf16* sKh = (bf16*)(smem + L_T0); bf16* sVt = (bf16*)(smem + L_T0 + 2 * L_TSZ); float* sz = (float*)(smem + L_T0 + 4 * L_TSZ);
  const size_t token0 = (size_t)b * TPB + chunk * 64;
  __syncthreads();
  gla_load_common(p, b, h, chunk, sz, sVt);
  __syncthreads();
  for (int dir = 0; dir < 2; ++dir) {
    gla_cumgate(p, layer, h, dir, sz, sb, stot);
    const int bend = dir == 0 ? 63 : 0; const int bhd = bh * 2 + dir;
    { const int s = tid & 63, dkg = tid >> 6;
      const u32x4* kp = (const u32x4*)(p.P + (token0 + s) * PW + PC_GK + h * 64 + dkg * 16);
      u32x4 k0 = kp[0], k1 = kp[1]; float kv[16];
#pragma unroll
      for (int e = 0; e < 4; ++e) { kv[2 * e] = bflo(k0[e]); kv[2 * e + 1] = bfhi(k0[e]); kv[8 + 2 * e] = bflo(k1[e]); kv[8 + 2 * e + 1] = bfhi(k1[e]); }
#pragma unroll
      for (int e = 0; e < 16; ++e) { const int dk = dkg * 16 + e; sKh[dk * TS + s] = f2bf(kv[e] * __expf(sb[bend * 65 + dk] - sb[s * 65 + dk])); } }
    if (tid < 64) p.DEC[((size_t)bhd * NCHUNK + chunk) * 64 + tid] = __expf(sb[bend * 65 + tid]);
    __syncthreads();
    f32x16 acc;
#pragma unroll
    for (int r = 0; r < 16; ++r) acc[r] = 0.f;
    acc = nt64(sVt, sKh, acc);
    float* dst = p.SlocT + ((size_t)bhd * NCHUNK + chunk) * 4096;
#pragma unroll
    for (int r = 0; r < 16; ++r) dst[(wi * 32 + crow(r, lh)) * 64 + wj * 32 + l31] = acc[r];
    __syncthreads();
  }
}

__device__ void gla_g2_item(const Params& p, int item) {
  const int bhd = item >> 2, part = item & 3, dir = bhd & 1; const int tid = threadIdx.x;
  const int e = part * 1024 + tid * 4, dk = e & 63;
  const float* sl = p.SlocT + (size_t)bhd * NCHUNK * 4096 + e; const float* dc = p.DEC + (size_t)bhd * NCHUNK * 64 + dk; bf16* sp = p.Sprev + (size_t)bhd * NCHUNK * 4096 + e;
  f32x4 S = {0.f, 0.f, 0.f, 0.f};
  int c = dir == 0 ? 0 : 3;
  f32x4 nsl = *(const f32x4*)(sl + (size_t)c * 4096), ndc = *(const f32x4*)(dc + c * 64);
  for (int s = 0; s < NCHUNK; ++s) {
    const f32x4 csl = nsl, cdc = ndc; const int cc = c;
    if (s + 1 < NCHUNK) { const int s1 = s + 1; c = dir == 0 ? s1 : (s1 < 4 ? 3 - s1 : 71 - s1); nsl = *(const f32x4*)(sl + (size_t)c * 4096); ndc = *(const f32x4*)(dc + c * 64); }
    u32x2 wv = {pk_bf16(S[0], S[1]), pk_bf16(S[2], S[3])};
    *(u32x2*)(sp + (size_t)cc * 4096) = wv;
    S = cdc * S + csl;
  }
}

__device__ void gla_g3_item(const Params& p, int layer, int item, char* smem) {
  const int chunk = item % NCHUNK, bh = item / NCHUNK, b = bh >> 2, h = bh & 3;
  const int tid = threadIdx.x, lane = tid & 63, w = tid >> 6, wi = w >> 1, wj = w & 1, l31 = lane & 31, lh = lane >> 5;
  float* sb = (float*)(smem + L_SB); float* stot = (float*)(smem + L_STOT);
  bf16* sQ = (bf16*)(smem + L_T0); bf16* sK = (bf16*)(smem + L_T0 + L_TSZ); bf16* sVt = (bf16*)(smem + L_T0 + 2 * L_TSZ); bf16* sS = (bf16*)(smem + L_T0 + 3 * L_TSZ);
  bf16* sAT = (bf16*)(smem + L_T0 + 4 * L_TSZ); float* sz = (float*)sAT; float* so = sb;
  const size_t token0 = (size_t)b * TPB + chunk * 64;
  __syncthreads();
  gla_load_common(p, b, h, chunk, sz, sVt);
  __syncthreads();
  f32x16 att, acc;
#pragma unroll
  for (int r = 0; r < 16; ++r) { att[r] = 0.f; acc[r] = 0.f; }
  for (int dir = 0; dir < 2; ++dir) {
    gla_cumgate(p, layer, h, dir, sz, sb, stot);
    const int bhd = bh * 2 + dir;
    { const int t = tid >> 2, kg = (tid & 3) * 16;
      const u32x4* qp = (const u32x4*)(p.P + (token0 + t) * PW + PC_GQ + h * 64 + kg);
      const u32x4* kp = (const u32x4*)(p.P + (token0 + t) * PW + PC_GK + h * 64 + kg);
      u32x4 q0 = qp[0], q1 = qp[1], k0 = kp[0], k1 = kp[1]; unsigned qo[8], ko[8];
#pragma unroll
      for (int e = 0; e < 8; ++e) { const unsigned qw = e < 4 ? q0[e] : q1[e - 4], kw = e < 4 ? k0[e] : k1[e - 4];
        const float b0 = sb[t * 65 + kg + 2 * e], b1 = sb[t * 65 + kg + 2 * e + 1];
        qo[e] = pk_bf16(bflo(qw) * __expf(b0), bfhi(qw) * __expf(b1)); ko[e] = pk_bf16(bflo(kw) * __expf(-b0), bfhi(kw) * __expf(-b1)); }
      u32x4 w0 = {qo[0], qo[1], qo[2], qo[3]}, w1 = {qo[4], qo[5], qo[6], qo[7]}, w2 = {ko[0], ko[1], ko[2], ko[3]}, w3 = {ko[4], ko[5], ko[6], ko[7]};
      *(u32x4*)(sQ + t * TS + kg) = w0; *(u32x4*)(sQ + t * TS + kg + 8) = w1; *(u32x4*)(sK + t * TS + kg) = w2; *(u32x4*)(sK + t * TS + kg + 8) = w3; }
#pragma unroll
    for (int i = 0; i < 2; ++i) { int it = tid + 256 * i; int dv = it >> 3, ch = it & 7;
      *(u32x4*)(sS + dv * TS + ch * 8) = *(const u32x4*)(p.Sprev + ((size_t)bhd * NCHUNK + chunk) * 4096 + dv * 64 + ch * 8); }
    __syncthreads();
    f32x16 a;
#pragma unroll
    for (int r = 0; r < 16; ++r) a[r] = 0.f;
    a = nt64(sQ, sK, a);
#pragma unroll
    for (int r = 0; r < 16; ++r) { const int t = wi * 32 + crow(r, lh), s = wj * 32 + l31; const bool keep = dir == 0 ? (s <= t) : (s >= t); att[r] += keep ? a[r] : 0.f; }
    acc = nt64(sQ, sS, acc);
    __syncthreads();
  }
#pragma unroll
  for (int r = 0; r < 16; ++r) sAT[(wi * 32 + crow(r, lh)) * TS + wj * 32 + l31] = f2bf(att[r]);
  __syncthreads();
  acc = nt64(sAT, sVt, acc);
#pragma unroll
  for (int r = 0; r < 16; ++r) so[(wi * 32 + crow(r, lh)) * 65 + wj * 32 + l31] = acc[r];
  __syncthreads();
  { const int t = tid >> 2, part = tid & 3; float o[16]; float ss = 0.f;
#pragma unroll
    for (int e = 0; e < 16; ++e) { o[e] = so[t * 65 + part * 16 + e]; ss += o[e] * o[e]; }
    ss += __shfl_xor(ss, 1); ss += __shfl_xor(ss, 2);
    const float rn = rsqrtf(ss * (1.f / 64.f) + 1e-6f);
    const u32x4* gp = (const u32x4*)(p.P + (token0 + t) * PW + PC_GO + h * 64 + part * 16);
    u32x4 g0 = gp[0], g1 = gp[1]; unsigned ow[8]; const float* gn = p.gla_g + layer * 64 + part * 16;
#pragma unroll
    for (int e = 0; e < 8; ++e) { const unsigned gw = e < 4 ? g0[e] : g1[e - 4]; const float ga = bflo(gw), gb = bfhi(gw);
      const float y0 = o[2 * e] * rn * gn[2 * e] * (ga / (1.f + __expf(-ga))), y1 = o[2 * e + 1] * rn * gn[2 * e + 1] * (gb / (1.f + __expf(-gb)));
      ow[e] = pk_bf16(y0, y1); }
    u32x4 w0 = {ow[0], ow[1], ow[2], ow[3]}, w1 = {ow[4], ow[5], ow[6], ow[7]};
    bf16* dst = p.MIX + (token0 + t) * DM + h * 64 + part * 16;
    *(u32x4*)dst = w0; *(u32x4*)(dst + 8) = w1; }
  __syncthreads();
}

template <int DH>
__device__ void flash128(const bf16* Q, const bf16* K, const bf16* Vt, int s0a, int s0b, int s1a, int s1b, bool win, int qtok0, float m0, float l0, f32x16 (&O)[2], char* smem) {
  constexpr int KS = DH + 8; constexpr int NKC = DH / 32;
  const int tid = threadIdx.x, lane = tid & 63, w = tid >> 6, l31 = lane & 31, lh = lane >> 5;
  bf16* sK = (bf16*)smem; bf16* sV = sK + 64 * TS;
  bf16x8 qf[DH / 16];
  { const bf16* qp = Q + (size_t)(w * 32 + l31) * PW + lh * 8;
#pragma unroll
    for (int ks = 0; ks < DH / 16; ++ks) qf[ks] = *(const bf16x8*)(qp + ks * 16); }
  float m = m0, l = lh == 0 ? l0 : 0.f;
#pragma unroll
  for (int r = 0; r < 16; ++r) { O[0][r] = 0.f; O[1][r] = 0.f; }
  const int nt0 = (s0b - s0a) >> 6, nt1 = (s1b - s1a) >> 6, ntile = nt0 + nt1;
  u32x4 rk[NKC], rv[2];
  auto tstart = [&](int t) { return t < nt0 ? s0a + t * 64 : s1a + (t - nt0) * 64; };
  auto gload = [&](int t) { const int key0 = tstart(t);
#pragma unroll
    for (int i = 0; i < NKC; ++i) { int it = tid + 256 * i; int row = it / (DH / 8), ch = it % (DH / 8); rk[i] = *(const u32x4*)(K + (size_t)(key0 + row) * PW + ch * 8); }
#pragma unroll
    for (int i = 0; i < 2; ++i) { int it = tid + 256 * i; int dv = it >> 3, ch = it & 7; rv[i] = *(const u32x4*)(Vt + (size_t)dv * TPB + key0 + ch * 8); } };
  gload(0);
  for (int t = 0; t < ntile; ++t) {
    __syncthreads();
#pragma unroll
    for (int i = 0; i < NKC; ++i) { int it = tid + 256 * i; int row = it / (DH / 8), ch = it % (DH / 8); *(u32x4*)(sK + row * KS + ch * 8) = rk[i]; }
#pragma unroll
    for (int i = 0; i < 2; ++i) { int it = tid + 256 * i; int dv = it >> 3, ch = it & 7; *(u32x4*)(sV + dv * TS + ch * 8) = rv[i]; }
    __syncthreads();
    const int key0 = tstart(t); const bool domask = win && t >= nt0;
    if (t + 1 < ntile) gload(t + 1);
    f32x16 X[2];
#pragma unroll
    for (int kt2 = 0; kt2 < 2; ++kt2) {
#pragma unroll
      for (int r = 0; r < 16; ++r) X[kt2][r] = 0.f;
#pragma unroll
      for (int ks = 0; ks < DH / 16; ++ks) { bf16x8 a = *(const bf16x8*)(sK + (kt2 * 32 + l31) * KS + ks * 16 + lh * 8); X[kt2] = MFMA32(a, qf[ks], X[kt2]); }
    }
    if (domask) { const int qtok = qtok0 + w * 32 + l31;
#pragma unroll
      for (int kt2 = 0; kt2 < 2; ++kt2)
#pragma unroll
        for (int r = 0; r < 16; ++r) { const int d = key0 + kt2 * 32 + crow(r, lh) - qtok; if (d > 128 || d < -128) X[kt2][r] = -1e30f; } }
    float tmax = X[0][0];
#pragma unroll
    for (int r = 1; r < 16; ++r) tmax = fmaxf(tmax, X[0][r]);
#pragma unroll
    for (int r = 0; r < 16; ++r) tmax = fmaxf(tmax, X[1][r]);
    tmax = fmaxf(tmax, __shfl_xor(tmax, 32));
    const float mn = fmaxf(m, tmax); const float alpha = __expf(m - mn); m = mn;
    float ps = 0.f;
#pragma unroll
    for (int kt2 = 0; kt2 < 2; ++kt2)
#pragma unroll
      for (int r = 0; r < 16; ++r) { const float pv = __expf(X[kt2][r] - mn); X[kt2][r] = pv; ps += pv; }
    l = l * alpha + ps;
#pragma unroll
    for (int r = 0; r < 16; ++r) { O[0][r] *= alpha; O[1][r] *= alpha; }
#pragma unroll
    for (int kt2 = 0; kt2 < 2; ++kt2)
#pragma unroll
      for (int s = 0; s < 2; ++s) {
        u32x4 pw = {pk_bf16(X[kt2][8 * s], X[kt2][8 * s + 1]), pk_bf16(X[kt2][8 * s + 2], X[kt2][8 * s + 3]), pk_bf16(X[kt2][8 * s + 4], X[kt2][8 * s + 5]), pk_bf16(X[kt2][8 * s + 6], X[kt2][8 * s + 7])};
        bf16x8 pb = *reinterpret_cast<bf16x8*>(&pw);
#pragma unroll
        for (int dt = 0; dt < 2; ++dt) {
          const bf16* vp = sV + (dt * 32 + l31) * TS + kt2 * 32 + s * 16 + lh * 4;
          u32x2 lo = *(const u32x2*)vp, hi = *(const u32x2*)(vp + 8);
          u32x4 vw = {lo[0], lo[1], hi[0], hi[1]};
          bf16x8 va = *reinterpret_cast<bf16x8*>(&vw);
          O[dt] = MFMA32(va, pb, O[dt]);
        }
      }
  }
  l += __shfl_xor(l, 32);
  const float inv = 1.f / l;
#pragma unroll
  for (int r = 0; r < 16; ++r) { O[0][r] *= inv; O[1][r] *= inv; }
}

__device__ __forceinline__ void store_ot(bf16* base  , const f32x16 (&O)[2]) {
  const int lane = threadIdx.x & 63, w = threadIdx.x >> 6, l31 = lane & 31, lh = lane >> 5;
  bf16* rowp = base + (size_t)(w * 32 + l31) * DM;
#pragma unroll
  for (int dt = 0; dt < 2; ++dt)
#pragma unroll
    for (int g = 0; g < 4; ++g) { u32x2 wv = {pk_bf16(O[dt][4 * g], O[dt][4 * g + 1]), pk_bf16(O[dt][4 * g + 2], O[dt][4 * g + 3])};
      *(u32x2*)(rowp + dt * 32 + 8 * g + 4 * lh) = wv; }
}

__device__ void diff_item(const Params& p, int layer, int item, char* smem) {
  const int qb = 33 - item / 32, bh = item % 32, b = bh >> 2, h = bh & 3;
  const int lane = threadIdx.x & 63, lh = lane >> 5;
  const bool isctx = qb < 2; const int kend = isctx ? CTXL : TPB;
  const size_t qrow0 = (size_t)b * TPB + qb * 128;
  const bf16* Kb = p.P + (size_t)b * TPB * PW + PC_DK + h * 64; const bf16* Vt = p.DVt + ((size_t)b * 256 + h * 64) * TPB;
  f32x16 O1[2], O2[2];
  flash128<32>(p.P + qrow0 * PW + PC_DQ + h * 64, Kb, Vt, 0, kend, 0, 0, false, 0, -1e30f, 0.f, O1, smem);
  flash128<32>(p.P + qrow0 * PW + PC_DQ + h * 64 + 32, Kb + 32, Vt, 0, kend, 0, 0, false, 0, -1e30f, 0.f, O2, smem);
  const float lam = p.LAM[layer * 2], li = p.LAM[layer * 2 + 1];
  float ss = 0.f;
#pragma unroll
  for (int dt = 0; dt < 2; ++dt)
#pragma unroll
    for (int r = 0; r < 16; ++r) { const float o = O1[dt][r] - lam * O2[dt][r]; O1[dt][r] = o; ss += o * o; }
  ss += __shfl_xor(ss, 32);
  const float rn = rsqrtf(ss * (1.f / 64.f) + 1e-6f) * (1.f - li);
  const float* g = p.diff_g + layer * 64;
#pragma unroll
  for (int dt = 0; dt < 2; ++dt)
#pragma unroll
    for (int r = 0; r < 16; ++r) O1[dt][r] *= rn * g[dt * 32 + crow(r, lh)];
  store_ot(p.MIX + qrow0 * DM + 256 + h * 64, O1);
}

__device__ void swa_item(const Params& p, int layer, int item, char* smem) {
  const int qb = item / 64, bhh = item % 64, b = bhh >> 3, hh = bhh & 7, g = hh >> 2;
  const bool isctx = qb < 2; const size_t qrow0 = (size_t)b * TPB + qb * 128;
  const bf16* Kb = p.P + (size_t)b * TPB * PW + PC_SK + g * 64; const bf16* Vt = p.SVt + ((size_t)b * 128 + g * 64) * TPB;
  int s1a = 0, s1b = 0;
  if (!isctx) { const int i = qb - 2; int lo = 128 * (i - 1), hi = 128 * (i + 2); lo = lo < 0 ? 0 : lo; hi = hi > SEQL ? SEQL : hi; s1a = CTXL + lo; s1b = CTXL + hi; }
  f32x16 O[2];
  flash128<64>(p.P + qrow0 * PW + PC_SQ + hh * 64, Kb, Vt, 0, CTXL, s1a, s1b, true, qb * 128, p.sink[layer * 8 + hh], 1.f, O, smem);
  store_ot(p.MIX + qrow0 * DM + 512 + hh * 64, O);
}

enum { PH_PREP = 0, PH_ROW, PH_INPROJ, PH_M1, PH_M2, PH_G3, PH_OUTPROJ, PH_FFNUP, PH_FFNDOWN };
constexpr int N_G1 = NBATCH * 4 * NCHUNK  , N_SWA = 34 * 64  , N_G2 = 256, N_DIFF = 34 * 32  ;

template <int PH> __device__ __forceinline__ int phase_items() {
  return PH == PH_PREP ? PREP_ITEMS : PH == PH_ROW ? TTOK / 4 : PH == PH_INPROJ ? 272 * 21 : PH == PH_M1 ? N_G1 + N_SWA : PH == PH_M2 ? N_G2 + N_DIFF :
         PH == PH_G3 ? N_G1 : PH == PH_OUTPROJ ? 272 * 8 : PH == PH_FFNUP ? 272 * 44 : 272 * 8;
}
template <int PH> __device__ __forceinline__ void run_item(const Params& p, int layer, int sub, int item, char* smem) {
  if (PH == PH_PREP) prep_item(p, item, smem);
  else if (PH == PH_ROW) rowpass_item(p, layer, sub, item);
  else if (PH == PH_INPROJ) gemm_item<G_INPROJ>(p, layer, item, smem);
  else if (PH == PH_M1) { if (item < N_G1) gla_g1_item(p, layer, item, smem); else { __syncthreads(); swa_item(p, layer, item - N_G1, smem); } }
  else if (PH == PH_M2) { if (item < N_G2) gla_g2_item(p, item); else { __syncthreads(); diff_item(p, layer, item - N_G2, smem); } }
  else if (PH == PH_G3) gla_g3_item(p, layer, item, smem);
  else if (PH == PH_OUTPROJ) gemm_item<G_OUTPROJ>(p, layer, item, smem);
  else if (PH == PH_FFNUP) gemm_item<G_FFNUP>(p, layer, item, smem);
  else gemm_item<G_FFNDOWN>(p, layer, item, smem);
}
template <int PH> __device__ __forceinline__ void run_phase(const Params& p, int layer, int sub, char* smem) {
  const int n = phase_items<PH>();
  for (int item = blockIdx.x; item < n; item += gridDim.x) run_item<PH>(p, layer, sub, item, smem);
}

template <int PH> __global__ void __launch_bounds__(256) k_phase(Params p, int layer, int sub) {
  __shared__ __attribute__((aligned(16))) char smem[SMEM_BYTES];
  run_phase<PH>(p, layer, sub, smem);
}

__global__ void __launch_bounds__(256) k_mega(Params p) {
  __shared__ __attribute__((aligned(16))) char smem[SMEM_BYTES];
  cg::grid_group grid = cg::this_grid();
  run_phase<PH_PREP>(p, 0, 0, smem);
  grid.sync();
  for (int layer = 0; layer < DEPTH; ++layer) {
    run_phase<PH_ROW>(p, layer, 0, smem); grid.sync();
    run_phase<PH_INPROJ>(p, layer, 0, smem); grid.sync();
    run_phase<PH_M1>(p, layer, 0, smem); grid.sync();
    run_phase<PH_M2>(p, layer, 0, smem); grid.sync();
    run_phase<PH_G3>(p, layer, 0, smem); grid.sync();
    run_phase<PH_OUTPROJ>(p, layer, 0, smem); grid.sync();
    run_phase<PH_ROW>(p, layer, 1, smem); grid.sync();
    run_phase<PH_FFNUP>(p, layer, 0, smem); grid.sync();
    run_phase<PH_FFNDOWN>(p, layer, 0, smem); grid.sync();
  }
  run_phase<PH_ROW>(p, DEPTH, 0, smem);
}

extern "C" void kernel_launch(void* const* d_in, const int* in_sizes, int n_in, void* d_out, int out_size, void* d_ws, size_t ws_size, hipStream_t stream) {
  Params p{};
  p.x = (const float*)d_in[0]; p.c = (const float*)d_in[1]; p.ctx = (const float*)d_in[2]; p.c_ctx = (const float*)d_in[3];
  p.w_ada = (const float*)d_in[4]; p.b_ada = (const float*)d_in[5]; p.w_in = (const float*)d_in[6]; p.w_gg = (const float*)d_in[7]; p.b_gg = (const float*)d_in[8];
  p.gla_g = (const float*)d_in[9]; p.dlam = (const float*)d_in[10]; p.diff_g = (const float*)d_in[11]; p.sink = (const float*)d_in[12]; p.w_out = (const float*)d_in[13];
  p.ln_g = (const float*)d_in[14]; p.ln_b = (const float*)d_in[15]; p.w_fg = (const float*)d_in[16]; p.w_fu = (const float*)d_in[17]; p.w_fd = (const float*)d_in[18];
  p.out = (float*)d_out;
  char* ws = (char*)d_ws; size_t off = 0;
  auto take = [&](size_t bytes) { char* r = ws + off; off += (bytes + 255) & ~(size_t)255; return r; };
  p.Z = (float*)take((size_t)TTOK * DM * 4);
  p.MIX = (bf16*)take((size_t)TTOK * DM * 2);
  p.P = (bf16*)take((size_t)TTOK * PW * 2);
  p.HID = p.MIX;
  p.GVt = (bf16*)take((size_t)NBATCH * 256 * TPB * 2);
  p.DVt = (bf16*)take((size_t)NBATCH * 256 * TPB * 2);
  p.SVt = (bf16*)take((size_t)NBATCH * 128 * TPB * 2);
  p.GZ = (float*)take((size_t)TTOK * 32 * 4);
  p.WinT = (bf16*)take((size_t)DEPTH * WIN_ROWS * DM * 2);
  p.WoT = (bf16*)take((size_t)DEPTH * DM * DM * 2);
  p.WguT = (bf16*)take((size_t)DEPTH * 5632 * DM * 2);
  p.WdT = (bf16*)take((size_t)DEPTH * DM * FFNH * 2);
  p.MOD = (float*)take((size_t)DEPTH * 9 * 6144 * 4);
  p.ST = (float*)take((size_t)TTOK * 2 * 4);
  p.DEC = (float*)take((size_t)64 * NCHUNK * 64 * 4);
  p.TAB32 = (float*)take(64 * 8 * 2 * 4);
  p.TAB64 = (float*)take(64 * 16 * 2 * 4);
  p.LAM = (float*)take(256);
  if (off > ws_size) { fprintf(stderr, "workspace too small: need %zu have %zu\n", off, ws_size); return; }
  p.U = (bf16*)d_out;
  p.SlocT = (float*)d_out;
  p.Sprev = (bf16*)((char*)d_out + (size_t)TTOK * DM * 2);
#if MEGA
  static int grid_blocks = 0;
  if (!grid_blocks) { int dev = 0, cus = 0, per_cu = 0; hipGetDevice(&dev); hipDeviceGetAttribute(&cus, hipDeviceAttributeMultiprocessorCount, dev);
    hipOccupancyMaxActiveBlocksPerMultiprocessor(&per_cu, k_mega, 256, 0); grid_blocks = cus * per_cu; }
  void* args[] = {&p};
  hipError_t e = hipLaunchCooperativeKernel((void*)k_mega, dim3(grid_blocks), dim3(256), args, 0, stream);
  if (e != hipSuccess) fprintf(stderr, "cooperative launch failed: %s (grid %d)\n", hipGetErrorString(e), grid_blocks);
#else
  const int G = 2048;
  k_phase<PH_PREP><<<G, 256, 0, stream>>>(p, 0, 0);
  for (int layer = 0; layer < DEPTH; ++layer) {
    k_phase<PH_ROW><<<G, 256, 0, stream>>>(p, layer, 0);
    k_phase<PH_INPROJ><<<G, 256, 0, stream>>>(p, layer, 0);
    k_phase<PH_M1><<<G, 256, 0, stream>>>(p, layer, 0);
    k_phase<PH_M2><<<G, 256, 0, stream>>>(p, layer, 0);
    k_phase<PH_G3><<<G, 256, 0, stream>>>(p, layer, 0);
    k_phase<PH_OUTPROJ><<<G, 256, 0, stream>>>(p, layer, 0);
    k_phase<PH_ROW><<<G, 256, 0, stream>>>(p, layer, 1);
    k_phase<PH_FFNUP><<<G, 256, 0, stream>>>(p, layer, 0);
    k_phase<PH_FFNDOWN><<<G, 256, 0, stream>>>(p, layer, 0);
  }
  k_phase<PH_ROW><<<G, 256, 0, stream>>>(p, DEPTH, 0);
#endif
}
```

```cpp
#include <hip/hip_runtime.h>
#include <hip/hip_cooperative_groups.h>
#include <stdint.h>
#include <stdio.h>
namespace cg = cooperative_groups;

#ifndef COOP
#define COOP 1
#endif
#ifndef DELAY_ITERS
#define DELAY_ITERS 0
#endif
#ifndef FUSE
#define FUSE 0x3FF
#endif
#ifndef MEGA
#define MEGA 1
#endif

typedef unsigned short bf16;
typedef __attribute__((ext_vector_type(8))) short bf16x8;
typedef __attribute__((ext_vector_type(4))) short bf16x4;
typedef __attribute__((ext_vector_type(16))) float f32x16;
typedef __attribute__((ext_vector_type(4))) float f32x4;
typedef __attribute__((ext_vector_type(4))) unsigned u32x4;
typedef __attribute__((ext_vector_type(2))) unsigned u32x2;

constexpr int DM = 1024, NBATCH = 8, SEQL = 4096, CTXL = 256, TPB = 4352, TTOK = 34816, DEPTH = 4, FFNH = 2816;
constexpr int NCHUNK = 68;
constexpr int PW = 1920;
constexpr int PC_GQ = 0, PC_GK = 256, PC_GO = 512, PC_DQ = 768, PC_DK = 1024, PC_SQ = 1280, PC_SK = 1792;
constexpr int WIN_ROWS = 2688;
constexpr float DN_ALPHA = 1.6817928305074292f;
constexpr int SMEM_BYTES = 61440;

struct Params {
  const float *x, *c, *ctx, *c_ctx, *w_ada, *b_ada, *w_in, *w_gg, *b_gg, *gla_g, *dlam, *diff_g, *sink, *w_out, *ln_g, *ln_b, *w_fg, *w_fu, *w_fd;
  float* out;
  float* Z; bf16* U; bf16* MIX; bf16* P; bf16* GVt; bf16* DVt; bf16* SVt; float* GZ; bf16* HID;
  float* SlocT; bf16* Sprev; float* DEC; float* MOD; float* ST; float* TAB32; float* TAB64; float* LAM; unsigned* BAR;
  bf16 *WinT, *WoT, *WguT, *WdT;
};

typedef float f32x2v __attribute__((ext_vector_type(2)));
typedef __bf16 bf16x2v __attribute__((ext_vector_type(2)));
__device__ __forceinline__ unsigned pk_bf16(float lo, float hi) { f32x2v f = {lo, hi}; bf16x2v b = __builtin_convertvector(f, bf16x2v); return __builtin_bit_cast(unsigned, b); }
__device__ __forceinline__ bf16 f2bf(float x) { return (bf16)(pk_bf16(x, 0.f) & 0xffffu); }
__device__ __forceinline__ float bf2f(unsigned short x) { return __uint_as_float(((unsigned)x) << 16); }
__device__ __forceinline__ float bflo(unsigned w) { return __uint_as_float(w << 16); }
__device__ __forceinline__ float bfhi(unsigned w) { return __uint_as_float(w & 0xffff0000u); }
__device__ __forceinline__ int crow(int r, int hi) { return (r & 3) + 8 * (r >> 2) + 4 * hi; }
__device__ __forceinline__ float wave_sum(float v) {
#pragma unroll
  for (int o = 32; o >= 1; o >>= 1) v += __shfl_xor(v, o);
  return v;
}
__device__ __forceinline__ int otid() { int t = threadIdx.x; asm volatile("" : "+v"(t)); return t; }
#define MFMA32(a, b, c) __builtin_amdgcn_mfma_f32_32x32x16_bf16((a), (b), (c), 0, 0, 0)

constexpr int PREP_T_PER_LAYER = 6032, PREP_T = 4 * PREP_T_PER_LAYER, PREP_MOD = 384, PREP_ITEMS = PREP_T + PREP_MOD + 1;

__device__ void transpose_tile(const float* src, int N, bf16* dst, int ldd, int n0, int k0, int drow0, char* smem) {
  float* tile = (float*)smem;
  const int tid = otid();
#pragma unroll
  for (int i = 0; i < 8; ++i) { int k = (tid >> 5) + 8 * i, n = tid & 31; tile[k * 33 + n] = src[(size_t)(k0 + k) * N + n0 + n]; }
  __syncthreads();
  { int n = tid >> 3, kg = tid & 7; float v[8];
#pragma unroll
    for (int e = 0; e < 8; ++e) v[e] = tile[(kg * 8 + e) * 33 + n];
    u32x4 w = {pk_bf16(v[0], v[1]), pk_bf16(v[2], v[3]), pk_bf16(v[4], v[5]), pk_bf16(v[6], v[7])};
    *(u32x4*)(dst + (size_t)(drow0 + n) * ldd + k0 + kg * 8) = w; }
  __syncthreads();
}

__device__ void prep_item(const Params& p, int item, char* smem) {
  const int tid = otid();
  if (item < PREP_T) {
    int l = item / PREP_T_PER_LAYER, ti = item % PREP_T_PER_LAYER;
    if (ti < 1296) { int nt = ti / 16, kt = ti % 16; int n0 = nt * 32; int dr = n0 < 1024 ? n0 : (n0 < 1056 ? 2560 + (n0 - 1024) : n0 - 32);
      transpose_tile(p.w_in + (size_t)l * 1024 * 2592, 2592, p.WinT + (size_t)l * WIN_ROWS * 1024, 1024, n0, kt * 64, dr, smem); }
    else if (ti < 1808) { ti -= 1296; int nt = ti / 16, kt = ti % 16;
      transpose_tile(p.w_out + (size_t)l * 1024 * 1024, 1024, p.WoT + (size_t)l * 1024 * 1024, 1024, nt * 32, kt * 64, nt * 32, smem); }
    else if (ti < 3216) { ti -= 1808; int nt = ti / 16, kt = ti % 16;
      transpose_tile(p.w_fg + (size_t)l * 1024 * FFNH, FFNH, p.WguT + (size_t)l * 5632 * 1024, 1024, nt * 32, kt * 64, nt * 64, smem); }
    else if (ti < 4624) { ti -= 3216; int nt = ti / 16, kt = ti % 16;
      transpose_tile(p.w_fu + (size_t)l * 1024 * FFNH, FFNH, p.WguT + (size_t)l * 5632 * 1024, 1024, nt * 32, kt * 64, nt * 64 + 32, smem); }
    else { ti -= 4624; int nt = ti / 44, kt = ti % 44;
      transpose_tile(p.w_fd + (size_t)l * FFNH * 1024, 1024, p.WdT + (size_t)l * 1024 * FFNH, FFNH, nt * 32, kt * 64, nt * 32, smem); }
  } else if (item < PREP_T + PREP_MOD) {
    int mi = item - PREP_T; int l = mi / 96, cb = mi % 96;
    float* sv = (float*)smem;
    float* red = sv + 9 * 1024;
    for (int idx = tid; idx < 9216; idx += 256) { int m = idx >> 10, k = idx & 1023; float v = m < 8 ? p.c[m * 1024 + k] : p.c_ctx[k]; sv[idx] = v / (1.f + expf(-v)); }
    __syncthreads();
    int kp = tid >> 6, col = tid & 63; float acc[9];
#pragma unroll
    for (int m = 0; m < 9; ++m) acc[m] = 0.f;
    const float* wp = p.w_ada + ((size_t)l * 1024 + kp * 256) * 6144 + cb * 64 + col;
#pragma unroll 16
    for (int k = 0; k < 256; ++k) { float wv = wp[(size_t)k * 6144];
#pragma unroll
      for (int m = 0; m < 9; ++m) acc[m] += sv[m * 1024 + kp * 256 + k] * wv; }
#pragma unroll
    for (int m = 0; m < 9; ++m) red[(kp * 9 + m) * 64 + col] = acc[m];
    __syncthreads();
    for (int idx = tid; idx < 576; idx += 256) { int m = idx >> 6, cc = idx & 63;
      float s = red[(0 * 9 + m) * 64 + cc] + red[(1 * 9 + m) * 64 + cc] + red[(2 * 9 + m) * 64 + cc] + red[(3 * 9 + m) * 64 + cc] + p.b_ada[l * 6144 + cb * 64 + cc];
      p.MOD[((size_t)l * 9 + m) * 6144 + cb * 64 + cc] = s; }
    __syncthreads();
  } else {
    if (tid < 64) { int pos = tid;
      for (int f = 0; f < 8; ++f) { float inv = exp2f(-(float)f / 8.f * 13.287712379549449f); float a = (float)pos * inv; p.TAB32[(pos * 8 + f) * 2] = cosf(a); p.TAB32[(pos * 8 + f) * 2 + 1] = sinf(a); }
      for (int f = 0; f < 16; ++f) { float inv = exp2f(-(float)f / 16.f * 13.287712379549449f); float a = (float)pos * inv; p.TAB64[(pos * 16 + f) * 2] = cosf(a); p.TAB64[(pos * 16 + f) * 2 + 1] = sinf(a); }
    }
    if (tid >= 64 && tid < 68) { int l = tid - 64; const float* d = p.dlam + l * 128; float s1 = 0.f, s2 = 0.f;
      for (int i = 0; i < 32; ++i) { s1 += d[i] * d[32 + i]; s2 += d[64 + i] * d[96 + i]; }
      float li = 0.8f - 0.6f * expf(-0.3f * (float)l);
      p.LAM[l * 2] = expf(s1) - expf(s2) + li; p.LAM[l * 2 + 1] = li; }
  }
}

__device__ void rowpass_row(const Params& p, int layer, int sub, int row, int lane) {
  const int b = row / TPB, tin = row % TPB; const bool isctx = tin < CTXL;
  const bool first = (layer == 0 && sub == 0);
  if (layer == DEPTH - 1 && sub == 1 && isctx) return;
  const float* src = first ? (isctx ? p.ctx + ((size_t)b * CTXL + tin) * DM : p.x + ((size_t)b * SEQL + (tin - CTXL)) * DM) : p.Z + (size_t)row * DM;
  f32x4 v[4];
#pragma unroll
  for (int i = 0; i < 4; ++i) v[i] = *(const f32x4*)(src + i * 256 + lane * 4);
  if (!first) {
    float s = 0.f;
#pragma unroll
    for (int i = 0; i < 4; ++i) s += (v[i][0] + v[i][1]) + (v[i][2] + v[i][3]);
    const float mean = wave_sum(s) * (1.f / 1024.f);
    float q = 0.f;
#pragma unroll
    for (int i = 0; i < 4; ++i) { f32x4 d = v[i] - mean; q += (d[0] * d[0] + d[1] * d[1]) + (d[2] * d[2] + d[3] * d[3]); }
    const float rstd = rsqrtf(wave_sum(q) * (1.f / 1024.f) + 1e-6f);
    if (lane == 0) { p.ST[row * 2] = mean; p.ST[row * 2 + 1] = rstd; }
    const int gl = sub == 0 ? (layer - 1) * 2 + 1 : layer * 2;
    const float* g = p.ln_g + (size_t)gl * DM; const float* bb = p.ln_b + (size_t)gl * DM;
#pragma unroll
    for (int i = 0; i < 4; ++i) { f32x4 gv = *(const f32x4*)(g + i * 256 + lane * 4), bv = *(const f32x4*)(bb + i * 256 + lane * 4); v[i] = (v[i] - mean) * rstd * gv + bv; }
  } else {
    if (lane == 0) { p.ST[row * 2] = 0.f; p.ST[row * 2 + 1] = 1.f; }
#pragma unroll
    for (int i = 0; i < 4; ++i) *(f32x4*)(p.Z + (size_t)row * DM + i * 256 + lane * 4) = v[i];
  }
  if (layer == DEPTH) {
    float fac = 1.f;
#if MEGA
#endif
    if (!isctx) { float* o = p.out + ((size_t)b * SEQL + (tin - CTXL)) * DM;
#pragma unroll
      for (int i = 0; i < 4; ++i) *(f32x4*)(o + i * 256 + lane * 4) = v[i] * fac; }
    return;
  }
  float s = 0.f;
#pragma unroll
  for (int i = 0; i < 4; ++i) s += (v[i][0] + v[i][1]) + (v[i][2] + v[i][3]);
  const float mean2 = wave_sum(s) * (1.f / 1024.f);
  float q = 0.f;
#pragma unroll
  for (int i = 0; i < 4; ++i) { f32x4 d = v[i] - mean2; q += (d[0] * d[0] + d[1] * d[1]) + (d[2] * d[2] + d[3] * d[3]); }
  const float rstd2 = rsqrtf(wave_sum(q) * (1.f / 1024.f) + 1e-6f);
  const int msel = isctx ? 8 : b;
  const float* md = p.MOD + ((size_t)layer * 9 + msel) * 6144;
  const float* sh = md + (sub ? 3 : 0) * DM; const float* sc = md + (sub ? 4 : 1) * DM;
#pragma unroll
  for (int i = 0; i < 4; ++i) { f32x4 shv = *(const f32x4*)(sh + i * 256 + lane * 4), scv = *(const f32x4*)(sc + i * 256 + lane * 4);
    f32x4 u = (v[i] - mean2) * rstd2 * (scv + 1.f) + shv;
    u32x2 wv = {pk_bf16(u[0], u[1]), pk_bf16(u[2], u[3])};
    *(u32x2*)(p.U + (size_t)row * DM + i * 256 + lane * 4) = wv; }
}

__device__ void rowpass_item(const Params& p, int layer, int sub, int item) {
  const int tid = otid(); const int w = tid >> 6, lane = tid & 63;
#pragma unroll
  for (int i = 0; i < 4; ++i) rowpass_row(p, layer, sub, item * 16 + w * 4 + i, lane);
}

constexpr int GLS = 40;
enum { G_INPROJ = 0, G_OUTPROJ = 1, G_FFNUP = 2, G_FFNDOWN = 3 };

template <int MODE>
__device__ void gemm_item(const Params& p, int layer, int xcd, int q, char* smem) {
  constexpr int NTN = MODE == G_INPROJ ? 21 : (MODE == G_FFNUP ? 44 : 8);
  constexpr int K = MODE == G_FFNDOWN ? FFNH : DM;
  constexpr int BM = (MODE == G_INPROJ || MODE == G_FFNUP) ? 256 : 128;
  constexpr int MI = BM / 64, BAND = 4352 / BM, STRIP = BAND * 8;
  constexpr int NS = NTN / 8, REM = NTN % 8;
  const int sidx = q / STRIP; const int sw = sidx < NS ? 8 : REM; const int base = (sidx < NS ? sidx : NS) * STRIP; const int c0 = (sidx < NS ? sidx : NS) * 8;
  const int mt = BAND * xcd + (q - base) / sw, nt = c0 + (q - base) % sw; const int m0 = mt * BM, n0 = nt * 128;
  if (MODE != G_INPROJ && layer == DEPTH - 1 && (m0 % TPB) < CTXL) return;
  const bf16* A; const bf16* Bt; int lda = K, ldb = K;
  if (MODE == G_INPROJ) { A = p.U; Bt = p.WinT + (size_t)layer * WIN_ROWS * DM; }
  else if (MODE == G_OUTPROJ) { A = p.MIX; Bt = p.WoT + (size_t)layer * DM * DM; }
  else if (MODE == G_FFNUP) { A = p.U; Bt = p.WguT + (size_t)layer * 5632 * DM; }
  else { A = p.HID; Bt = p.WdT + (size_t)layer * DM * FFNH; }
  const int tid = otid(), lane = tid & 63, w = tid >> 6, wm = w >> 1, wn = w & 1, l31 = lane & 31, lh = lane >> 5;
  constexpr int BK = 64, LS = 72, NA = BM / 32;
  bf16* sA = (bf16*)smem; bf16* sB = sA + BM * LS;
  const int r0 = tid >> 3, kc = (tid & 7) * 8;
  const bf16* a0 = A + (size_t)(m0 + r0) * lda + kc; const bf16* b0 = Bt + (size_t)(n0 + r0) * ldb + kc;
  const size_t a32 = (size_t)32 * lda, b32 = (size_t)32 * ldb;
  const int so0 = r0 * LS + kc;
  u32x4 sa[NA], sb[4];
#define G_LOAD(KT) do { const int ko_ = (KT) * BK; _Pragma("unroll") for (int u = 0; u < NA; ++u) sa[u] = *(const u32x4*)(a0 + u * a32 + ko_); _Pragma("unroll") for (int u = 0; u < 4; ++u) sb[u] = *(const u32x4*)(b0 + u * b32 + ko_); } while (0)
#define G_STORE() do { _Pragma("unroll") for (int u = 0; u < NA; ++u) *(u32x4*)(sA + so0 + u * 32 * LS) = sa[u]; _Pragma("unroll") for (int u = 0; u < 4; ++u) *(u32x4*)(sB + so0 + u * 32 * LS) = sb[u]; } while (0)
#define G_COMPUTE() do { const bf16* cA = sA + (wm * (BM / 2) + l31) * LS + lh * 8; const bf16* cB = sB + (wn * 64 + l31) * LS + lh * 8; \
    _Pragma("unroll") for (int ks = 0; ks < 4; ++ks) { bf16x8 af[MI], bfr[2]; \
      _Pragma("unroll") for (int i = 0; i < MI; ++i) af[i] = *(const bf16x8*)(cA + i * 32 * LS + ks * 16); \
      _Pragma("unroll") for (int jj = 0; jj < 2; ++jj) bfr[jj] = *(const bf16x8*)(cB + jj * 32 * LS + ks * 16); \
      _Pragma("unroll") for (int i = 0; i < MI; ++i) _Pragma("unroll") for (int jj = 0; jj < 2; ++jj) acc[i][jj] = MFMA32(af[i], bfr[jj], acc[i][jj]); } } while (0)
  f32x16 acc[MI][2];
#pragma unroll
  for (int i = 0; i < MI; ++i)
#pragma unroll
    for (int jj = 0; jj < 2; ++jj)
#pragma unroll
      for (int r = 0; r < 16; ++r) acc[i][jj][r] = 0.f;
  constexpr int NK = K / BK;
  G_LOAD(0);
  G_STORE();
  __syncthreads();
#pragma unroll 1
  for (int kt = 0; kt < NK; ++kt) {
    G_LOAD((kt + 1 < NK ? kt + 1 : NK - 1));
    asm volatile("" ::: "memory");
    G_COMPUTE();
    __syncthreads();
    G_STORE();
    __syncthreads();
  }
#undef G_LOAD
#undef G_STORE
#undef G_COMPUTE
  const int bidx = m0 / TPB, tin0 = m0 % TPB; const bool ctxtile = tin0 < CTXL; const int msel = ctxtile ? 8 : bidx;
  if (MODE == G_OUTPROJ || MODE == G_FFNDOWN) {
    const float* gate = p.MOD + ((size_t)layer * 9 + msel) * 6144 + (MODE == G_OUTPROJ ? 2 : 5) * DM;
    const bool haveln = !(MODE == G_OUTPROJ && layer == 0);
    const int gl = MODE == G_OUTPROJ ? (layer - 1) * 2 + 1 : layer * 2;
    const float* g = p.ln_g + (size_t)(haveln ? gl : 0) * DM; const float* bb = p.ln_b + (size_t)(haveln ? gl : 0) * DM;
    const int col0 = n0 + wn * 64 + l31;
    const float gt0 = gate[col0], gt1 = gate[col0 + 32];
    const float gv0 = haveln ? g[col0] : 1.f, gv1 = haveln ? g[col0 + 32] : 1.f, bv0 = haveln ? bb[col0] : 0.f, bv1 = haveln ? bb[col0 + 32] : 0.f;
#pragma unroll
    for (int i = 0; i < MI; ++i)
#pragma unroll
      for (int r = 0; r < 16; ++r) {
        const int row = m0 + wm * (BM / 2) + i * 32 + crow(r, lh);
        float* zp = p.Z + (size_t)row * DM + col0;
        const float mean = p.ST[row * 2], rstd = p.ST[row * 2 + 1];
        const float h0 = (zp[0] - mean) * rstd * gv0 + bv0, h1 = (zp[32] - mean) * rstd * gv1 + bv1;
        zp[0] = DN_ALPHA * h0 + gt0 * acc[i][0][r];
        zp[32] = DN_ALPHA * h1 + gt1 * acc[i][1][r];
        if (r == 15) asm volatile("" ::: "memory");
      }
  } else if (MODE == G_FFNUP) {
    bf16* sH = (bf16*)smem;
#pragma unroll
    for (int i = 0; i < MI; ++i)
#pragma unroll
      for (int r = 0; r < 16; ++r) {
        const float gg = acc[i][0][r], uu = acc[i][1][r];
        const float hv = gg * __builtin_amdgcn_rcpf(1.f + __expf(-gg)) * uu;
        sH[(wm * (BM / 2) + i * 32 + crow(r, lh)) * 72 + wn * 32 + l31] = f2bf(hv);
      }
    __syncthreads();
#pragma unroll
    for (int u = 0; u < BM / 32; ++u) { const int it = tid + 256 * u; const int row = it >> 3, ch = it & 7;
      *(u32x4*)(p.HID + (size_t)(m0 + row) * FFNH + n0 / 2 + ch * 8) = *(const u32x4*)(sH + row * 72 + ch * 8); }
    __syncthreads();
  } else {
    float* sC = (float*)smem;
    int mode, dcol = 0; float scale = 1.f; bf16* xt = nullptr; int xcols = 0, xcb = 0;
    if (nt < 2) { mode = 0; scale = 0.125f; dcol = PC_GQ + nt * 128; }
    else if (nt < 4) { mode = 0; dcol = PC_GK + (nt - 2) * 128; }
    else if (nt < 6) { mode = 3; xt = p.GVt; xcols = 256; xcb = (nt - 4) * 128; }
    else if (nt < 8) { mode = 0; dcol = PC_GO + (nt - 6) * 128; }
    else if (nt < 10) { mode = 1; scale = 0.17677669529663687f * 1.4426950408889634f; dcol = PC_DQ + (nt - 8) * 128; }
    else if (nt < 12) { mode = 1; dcol = PC_DK + (nt - 10) * 128; }
    else if (nt < 14) { mode = 3; xt = p.DVt; xcols = 256; xcb = (nt - 12) * 128; }
    else if (nt < 18) { mode = 2; scale = 0.125f * 1.4426950408889634f; dcol = PC_SQ + (nt - 14) * 128; }
    else if (nt < 19) { mode = 2; dcol = PC_SK; }
    else if (nt < 20) { mode = 3; xt = p.SVt; xcols = 128; xcb = 0; }
    else mode = 4;
    const int cs = mode == 3 ? 133 : 132;
#pragma unroll
    for (int half = 0; half < BM / 64; ++half) {
      if (wm == half / (MI / 2)) {
#pragma unroll
        for (int i = 0; i < 2; ++i)
#pragma unroll
          for (int j = 0; j < 2; ++j)
#pragma unroll
            for (int r = 0; r < 16; ++r) sC[(i * 32 + crow(r, lh)) * cs + wn * 64 + j * 32 + l31] = acc[(half % (MI / 2)) * 2 + i][j][r];
      }
      __syncthreads();
      if (mode <= 2) {
        for (int it = tid; it < 1024; it += 256) {
          const int row = it >> 4, cg8 = (it & 15) * 8; const int tin = tin0 + half * 64 + row; const size_t token = (size_t)m0 + half * 64 + row;
          float v[8];
          { const f32x4 v0 = *(const f32x4*)(sC + row * cs + cg8), v1 = *(const f32x4*)(sC + row * cs + cg8 + 4);
#pragma unroll
            for (int e = 0; e < 4; ++e) { v[e] = v0[e]; v[4 + e] = v1[e]; } }
          if (mode != 0 && !ctxtile) {
            const int dimh = mode == 1 ? 16 : 32; const int d = cg8 & (2 * dimh - 1); const bool second = d >= dimh; const int pi0 = second ? d - dimh : d;
            const int pcol = second ? cg8 - dimh : cg8 + dimh; const int nf = dimh >> 1; const bool usecol = pi0 >= nf; const int f0 = usecol ? pi0 - nf : pi0;
            const int pos = tin - CTXL; const int ps = usecol ? (pos & 63) : (pos >> 6);
            const float* tb = (mode == 1 ? p.TAB32 + (ps * 8 + f0) * 2 : p.TAB64 + (ps * 16 + f0) * 2);
            const f32x4 w0 = *(const f32x4*)(sC + row * cs + pcol), w1 = *(const f32x4*)(sC + row * cs + pcol + 4);
#pragma unroll
            for (int e2 = 0; e2 < 4; ++e2) { const f32x4 t4 = *(const f32x4*)(tb + e2 * 4);
#pragma unroll
              for (int h2 = 0; h2 < 2; ++h2) { const int e = e2 * 2 + h2; const float wv = e < 4 ? w0[e & 3] : w1[e & 3]; const float co = t4[h2 * 2], sn = t4[h2 * 2 + 1];
                v[e] = second ? (wv * sn + v[e] * co) : (v[e] * co - wv * sn); } }
          }
          u32x4 wv = {pk_bf16(v[0] * scale, v[1] * scale), pk_bf16(v[2] * scale, v[3] * scale), pk_bf16(v[4] * scale, v[5] * scale), pk_bf16(v[6] * scale, v[7] * scale)};
          *(u32x4*)(p.P + token * PW + dcol + cg8) = wv;
        }
      } else if (mode == 3) {
        for (int it = tid; it < 1024; it += 256) {
          const int col = it >> 3, g8 = it & 7; float v[8];
#pragma unroll
          for (int e = 0; e < 8; ++e) v[e] = sC[(g8 * 8 + e) * cs + col];
          u32x4 wv = {pk_bf16(v[0], v[1]), pk_bf16(v[2], v[3]), pk_bf16(v[4], v[5]), pk_bf16(v[6], v[7])};
          *(u32x4*)(xt + ((size_t)bidx * xcols + xcb + col) * TPB + tin0 + half * 64 + g8 * 8) = wv;
        }
      } else {
        for (int it = tid; it < 512; it += 256) { const int row = it >> 3, c4 = (it & 7) * 4; const size_t token = (size_t)m0 + half * 64 + row;
          const f32x4 o = *(const f32x4*)(sC + row * cs + c4);
          *(f32x4*)(p.GZ + token * 32 + c4) = o; }
      }
      __syncthreads();
    }
  }
}

constexpr int TS = 72;
__device__ __forceinline__ f32x16 nt64(const bf16* sA, const bf16* sB, f32x16 acc) {
  const int tid = otid(); const int lane = tid & 63, w = tid >> 6, wi = w >> 1, wj = w & 1, l31 = lane & 31, lh = lane >> 5;
#pragma unroll
  for (int ks = 0; ks < 4; ++ks) {
    bf16x8 a = *(const bf16x8*)(sA + (wi * 32 + l31) * TS + ks * 16 + lh * 8);
    bf16x8 b = *(const bf16x8*)(sB + (wj * 32 + l31) * TS + ks * 16 + lh * 8);
    acc = MFMA32(a, b, acc);
  }
  return acc;
}

__device__ void gla_cumgate(const Params& p, int layer, int h, int dir, const float* sz, float* sb, float* stot) {
  const int tid = otid(), qtr = tid >> 6, k = tid & 63;
  const float* W = p.w_gg + ((size_t)(layer * 2 + dir) * 16) * 256 + h * 64 + k;
  float wv[16];
#pragma unroll
  for (int r = 0; r < 16; ++r) wv[r] = W[r * 256];
  const float bias = p.b_gg[(layer * 2 + dir) * 256 + h * 64 + k];
  float cum = 0.f;
#pragma unroll 4
  for (int i = 0; i < 16; ++i) {
    const int t = dir == 0 ? qtr * 16 + i : qtr * 16 + 15 - i;
    float z = bias;
    { const f32x4* zr = (const f32x4*)(sz + t * 32 + dir * 16);
#pragma unroll
      for (int r4 = 0; r4 < 4; ++r4) { const f32x4 zv = zr[r4]; z += zv[0] * wv[4 * r4] + zv[1] * wv[4 * r4 + 1] + zv[2] * wv[4 * r4 + 2] + zv[3] * wv[4 * r4 + 3]; } }
    const float ls = fminf(z, 0.f) - __builtin_amdgcn_logf(1.f + __builtin_amdgcn_exp2f(-fabsf(z) * 1.4426950408889634f)) * 0.6931471805599453f;
    cum += ls * 0.0625f;
    sb[t * 65 + k] = cum;
  }
  stot[qtr * 64 + k] = cum;
  __syncthreads();
  float off = 0.f;
#pragma unroll
  for (int q = 0; q < 4; ++q) if (dir == 0 ? q < qtr : q > qtr) off += stot[q * 64 + k];
#pragma unroll 4
  for (int i = 0; i < 16; ++i) sb[(qtr * 16 + i) * 65 + k] += off;
  __syncthreads();
}

constexpr int L_SB = 0, L_T0 = 16640, L_TSZ = 64 * TS * 2  ;

__device__ void gla_load_common(const Params& p, int b, int h, int chunk, float* sz, bf16* sVt) {
  const int tid = otid(); const size_t token0 = (size_t)b * TPB + chunk * 64;
#pragma unroll
  for (int i = 0; i < 8; ++i) { int it = tid + 256 * i; sz[it] = p.GZ[token0 * 32 + it]; }
#pragma unroll
  for (int i = 0; i < 2; ++i) { int it = tid + 256 * i; int dv = it >> 3, ch = it & 7;
    *(u32x4*)(sVt + dv * TS + ch * 8) = *(const u32x4*)(p.GVt + ((size_t)b * 256 + h * 64 + dv) * TPB + chunk * 64 + ch * 8); }
}

__device__ void gla_g1_item(const Params& p, int layer, int item, char* smem) {
  const int chunk = item % NCHUNK, bh = item / NCHUNK, b = bh >> 2, h = bh & 3;
  const int tid = otid(), lane = tid & 63, w = tid >> 6, wi = w >> 1, wj = w & 1, l31 = lane & 31, lh = lane >> 5;
  float* sb = (float*)(smem + L_SB);
  bf16* sKh = (bf16*)(smem + L_T0); bf16* sVt = (bf16*)(smem + L_T0 + L_TSZ); float* sz = (float*)(smem + L_T0 + 2 * L_TSZ); float* stot = (float*)(smem + L_T0 + 2 * L_TSZ + 8192);
  const size_t token0 = (size_t)b * TPB + chunk * 64;
  __syncthreads();
  gla_load_common(p, b, h, chunk, sz, sVt);
  __syncthreads();
  for (int dir = 0; dir < 2; ++dir) {
    gla_cumgate(p, layer, h, dir, sz, sb, stot);
    const int bend = dir == 0 ? 63 : 0; const int bhd = bh * 2 + dir;
    { const int s = tid & 63, dkg = tid >> 6;
      const u32x4* kp = (const u32x4*)(p.P + (token0 + s) * PW + PC_GK + h * 64 + dkg * 16);
      u32x4 k0 = kp[0], k1 = kp[1]; float kv[16];
#pragma unroll
      for (int e = 0; e < 4; ++e) { kv[2 * e] = bflo(k0[e]); kv[2 * e + 1] = bfhi(k0[e]); kv[8 + 2 * e] = bflo(k1[e]); kv[8 + 2 * e + 1] = bfhi(k1[e]); }
#pragma unroll
      for (int e = 0; e < 16; ++e) { const int dk = dkg * 16 + e; sKh[dk * TS + s] = f2bf(kv[e] * __expf(sb[bend * 65 + dk] - sb[s * 65 + dk])); } }
    if (tid < 64) p.DEC[((size_t)bhd * NCHUNK + chunk) * 64 + tid] = __expf(sb[bend * 65 + tid]);
    __syncthreads();
    f32x16 acc;
#pragma unroll
    for (int r = 0; r < 16; ++r) acc[r] = 0.f;
    acc = nt64(sVt, sKh, acc);
    float* dst = p.SlocT + ((size_t)bhd * NCHUNK + chunk) * 4096;
#pragma unroll
    for (int r = 0; r < 16; ++r) dst[(wi * 32 + crow(r, lh)) * 64 + wj * 32 + l31] = acc[r];
    __syncthreads();
  }
}

__device__ void gla_g2_item(const Params& p, int item) {
  const int bhd = item >> 2, part = item & 3, dir = bhd & 1; const int tid = otid();
  const int e = part * 1024 + tid * 4, dk = e & 63;
  const float* sl = p.SlocT + (size_t)bhd * NCHUNK * 4096 + e; const float* dc = p.DEC + (size_t)bhd * NCHUNK * 64 + dk; bf16* sp = p.Sprev + (size_t)bhd * NCHUNK * 4096 + e;
  float z0 = 0.f; asm volatile("" : "+v"(z0));
  f32x4 S = {z0, z0, z0, z0};
  int c = dir == 0 ? 0 : 3;
  f32x4 nsl = *(const f32x4*)(sl + (size_t)c * 4096), ndc = *(const f32x4*)(dc + c * 64);
  for (int s = 0; s < NCHUNK; ++s) {
    const f32x4 csl = nsl, cdc = ndc; const int cc = c;
    if (s + 1 < NCHUNK) { const int s1 = s + 1; c = dir == 0 ? s1 : (s1 < 4 ? 3 - s1 : 71 - s1); nsl = *(const f32x4*)(sl + (size_t)c * 4096); ndc = *(const f32x4*)(dc + c * 64); }
    u32x2 wv = {pk_bf16(S[0], S[1]), pk_bf16(S[2], S[3])};
    *(u32x2*)(sp + (size_t)cc * 4096) = wv;
    S = cdc * S + csl;
  }
}

__device__ void gla_g3_item(const Params& p, int layer, int item, char* smem) {
  const int chunk = item % NCHUNK, bh = item / NCHUNK, b = bh >> 2, h = bh & 3;
  const int tid = otid(), lane = tid & 63, w = tid >> 6, wi = w >> 1, wj = w & 1, l31 = lane & 31, lh = lane >> 5;
  float* sb = (float*)(smem + L_SB);
  bf16* sQ = (bf16*)(smem + L_T0); bf16* sK = (bf16*)(smem + L_T0 + L_TSZ); bf16* sVt = (bf16*)(smem + L_T0 + 2 * L_TSZ); bf16* sS = (bf16*)(smem + L_T0 + 3 * L_TSZ);
  bf16* sAT = sK; float* sz = (float*)sS; float* stot = (float*)sQ; float* so = sb;
  const size_t token0 = (size_t)b * TPB + chunk * 64;
  __syncthreads();
  gla_load_common(p, b, h, chunk, sz, sVt);
  __syncthreads();
  f32x16 att, acc;
#pragma unroll
  for (int r = 0; r < 16; ++r) { att[r] = 0.f; acc[r] = 0.f; }
  for (int dir = 0; dir < 2; ++dir) {
    if (dir == 1) {
#pragma unroll
      for (int i = 0; i < 8; ++i) { int it = tid + 256 * i; sz[it] = p.GZ[token0 * 32 + it]; }
      __syncthreads(); }
    gla_cumgate(p, layer, h, dir, sz, sb, stot);
    const int bhd = bh * 2 + dir;
    { const int t = tid >> 2, kg = (tid & 3) * 16;
      const u32x4* qp = (const u32x4*)(p.P + (token0 + t) * PW + PC_GQ + h * 64 + kg);
      const u32x4* kp = (const u32x4*)(p.P + (token0 + t) * PW + PC_GK + h * 64 + kg);
      u32x4 q0 = qp[0], q1 = qp[1], k0 = kp[0], k1 = kp[1]; unsigned qo[8], ko[8];
#pragma unroll
      for (int e = 0; e < 8; ++e) { const unsigned qw = e < 4 ? q0[e] : q1[e - 4], kw = e < 4 ? k0[e] : k1[e - 4];
        const float b0 = sb[t * 65 + kg + 2 * e], b1 = sb[t * 65 + kg + 2 * e + 1];
        qo[e] = pk_bf16(bflo(qw) * __expf(b0), bfhi(qw) * __expf(b1)); ko[e] = pk_bf16(bflo(kw) * __expf(-b0), bfhi(kw) * __expf(-b1)); }
      u32x4 w0 = {qo[0], qo[1], qo[2], qo[3]}, w1 = {qo[4], qo[5], qo[6], qo[7]}, w2 = {ko[0], ko[1], ko[2], ko[3]}, w3 = {ko[4], ko[5], ko[6], ko[7]};
      *(u32x4*)(sQ + t * TS + kg) = w0; *(u32x4*)(sQ + t * TS + kg + 8) = w1; *(u32x4*)(sK + t * TS + kg) = w2; *(u32x4*)(sK + t * TS + kg + 8) = w3; }
#pragma unroll
    for (int i = 0; i < 2; ++i) { int it = tid + 256 * i; int dv = it >> 3, ch = it & 7;
      *(u32x4*)(sS + dv * TS + ch * 8) = *(const u32x4*)(p.Sprev + ((size_t)bhd * NCHUNK + chunk) * 4096 + dv * 64 + ch * 8); }
    __syncthreads();
    f32x16 a;
#pragma unroll
    for (int r = 0; r < 16; ++r) a[r] = 0.f;
    a = nt64(sQ, sK, a);
#pragma unroll
    for (int r = 0; r < 16; ++r) { const int t = wi * 32 + crow(r, lh), s = wj * 32 + l31; const bool keep = dir == 0 ? (s <= t) : (s >= t); att[r] += keep ? a[r] : 0.f; }
    acc = nt64(sQ, sS, acc);
    __syncthreads();
  }
#pragma unroll
  for (int r = 0; r < 16; ++r) sAT[(wi * 32 + crow(r, lh)) * TS + wj * 32 + l31] = f2bf(att[r]);
  __syncthreads();
  acc = nt64(sAT, sVt, acc);
#pragma unroll
  for (int r = 0; r < 16; ++r) so[(wi * 32 + crow(r, lh)) * 65 + wj * 32 + l31] = acc[r];
  __syncthreads();
  { const int t = tid >> 2, part = tid & 3; float o[16]; float ss = 0.f;
#pragma unroll
    for (int e = 0; e < 16; ++e) { o[e] = so[t * 65 + part * 16 + e]; ss += o[e] * o[e]; }
    ss += __shfl_xor(ss, 1); ss += __shfl_xor(ss, 2);
    const float rn = rsqrtf(ss * (1.f / 64.f) + 1e-6f);
    const u32x4* gp = (const u32x4*)(p.P + (token0 + t) * PW + PC_GO + h * 64 + part * 16);
    u32x4 g0 = gp[0], g1 = gp[1]; unsigned ow[8]; const float* gn = p.gla_g + layer * 64 + part * 16;
#pragma unroll
    for (int e = 0; e < 8; ++e) { const unsigned gw = e < 4 ? g0[e] : g1[e - 4]; const float ga = bflo(gw), gb = bfhi(gw);
      const float y0 = o[2 * e] * rn * gn[2 * e] * (ga * __builtin_amdgcn_rcpf(1.f + __expf(-ga))), y1 = o[2 * e + 1] * rn * gn[2 * e + 1] * (gb * __builtin_amdgcn_rcpf(1.f + __expf(-gb)));
      ow[e] = pk_bf16(y0, y1); }
    u32x4 w0 = {ow[0], ow[1], ow[2], ow[3]}, w1 = {ow[4], ow[5], ow[6], ow[7]};
    bf16* dst = p.MIX + (token0 + t) * DM + h * 64 + part * 16;
    *(u32x4*)dst = w0; *(u32x4*)(dst + 8) = w1; }
  __syncthreads();
}

template <int DH>
__device__ void flash128(const bf16* Q, const bf16* K, const bf16* Vt, int s0a, int s0b, int s1a, int s1b, bool win, int qtok0, float m0, float l0, f32x16 (&O)[2], char* smem) {
  constexpr int KS = DH + 8; constexpr int NKC = DH / 32;
  const int tid = otid(), lane = tid & 63, w = tid >> 6, l31 = lane & 31, lh = lane >> 5;
  bf16* sK = (bf16*)smem; bf16* sV = sK + 64 * TS;
  bf16x8 qf[DH / 16];
  { const bf16* qp = Q + (size_t)(w * 32 + l31) * PW + lh * 8;
#pragma unroll
    for (int ks = 0; ks < DH / 16; ++ks) qf[ks] = *(const bf16x8*)(qp + ks * 16); }
  float m = m0, l = lh == 0 ? l0 : 0.f;
#pragma unroll
  for (int r = 0; r < 16; ++r) { O[0][r] = 0.f; O[1][r] = 0.f; }
  const int nt0 = (s0b - s0a) >> 6, nt1 = (s1b - s1a) >> 6, ntile = nt0 + nt1;
  u32x4 rk[NKC], rv[2];
  auto tstart = [&](int t) { return t < nt0 ? s0a + t * 64 : s1a + (t - nt0) * 64; };
  auto gload = [&](int t) { const int key0 = tstart(t);
#pragma unroll
    for (int i = 0; i < NKC; ++i) { int it = tid + 256 * i; int row = it / (DH / 8), ch = it % (DH / 8); rk[i] = *(const u32x4*)(K + (size_t)(key0 + row) * PW + ch * 8); }
#pragma unroll
    for (int i = 0; i < 2; ++i) { int it = tid + 256 * i; int dv = it >> 3, ch = it & 7; rv[i] = *(const u32x4*)(Vt + (size_t)dv * TPB + key0 + ch * 8); } };
  gload(0);
  for (int t = 0; t < ntile; ++t) {
    __syncthreads();
#pragma unroll
    for (int i = 0; i < NKC; ++i) { int it = tid + 256 * i; int row = it / (DH / 8), ch = it % (DH / 8); *(u32x4*)(sK + row * KS + ch * 8) = rk[i]; }
#pragma unroll
    for (int i = 0; i < 2; ++i) { int it = tid + 256 * i; int dv = it >> 3, ch = it & 7; *(u32x4*)(sV + dv * TS + ch * 8) = rv[i]; }
    __syncthreads();
    const int key0 = tstart(t); const bool domask = win && t >= nt0;
    if (t + 1 < ntile) gload(t + 1);
    f32x16 X[2];
#pragma unroll
    for (int kt2 = 0; kt2 < 2; ++kt2) {
#pragma unroll
      for (int r = 0; r < 16; ++r) X[kt2][r] = 0.f;
#pragma unroll
      for (int ks = 0; ks < DH / 16; ++ks) { bf16x8 a = *(const bf16x8*)(sK + (kt2 * 32 + l31) * KS + ks * 16 + lh * 8); X[kt2] = MFMA32(a, qf[ks], X[kt2]); }
    }
    if (domask) { const int qtok = qtok0 + w * 32 + l31;
#pragma unroll
      for (int kt2 = 0; kt2 < 2; ++kt2)
#pragma unroll
        for (int r = 0; r < 16; ++r) { const int d = key0 + kt2 * 32 + crow(r, lh) - qtok; if (d > 128 || d < -128) X[kt2][r] = -1e30f; } }
    float tmax = X[0][0];
#pragma unroll
    for (int r = 1; r < 16; ++r) tmax = fmaxf(tmax, X[0][r]);
#pragma unroll
    for (int r = 0; r < 16; ++r) tmax = fmaxf(tmax, X[1][r]);
    tmax = fmaxf(tmax, __shfl_xor(tmax, 32));
    if (!__all(tmax <= m + 8.f)) {
      const float mn = fmaxf(m, tmax); const float alpha = __builtin_amdgcn_exp2f(m - mn); m = mn; l *= alpha;
#pragma unroll
      for (int r = 0; r < 16; ++r) { O[0][r] *= alpha; O[1][r] *= alpha; }
    }
    X[0] = X[0] - m; X[1] = X[1] - m;
#pragma unroll
    for (int kt2 = 0; kt2 < 2; ++kt2)
#pragma unroll
      for (int r = 0; r < 16; ++r) X[kt2][r] = __builtin_amdgcn_exp2f(X[kt2][r]);
    { const f32x16 sv = X[0] + X[1]; float ps = 0.f;
#pragma unroll
      for (int r = 0; r < 16; ++r) ps += sv[r];
      l += ps; }
#pragma unroll
    for (int kt2 = 0; kt2 < 2; ++kt2)
#pragma unroll
      for (int s = 0; s < 2; ++s) {
        u32x4 pw = {pk_bf16(X[kt2][8 * s], X[kt2][8 * s + 1]), pk_bf16(X[kt2][8 * s + 2], X[kt2][8 * s + 3]), pk_bf16(X[kt2][8 * s + 4], X[kt2][8 * s + 5]), pk_bf16(X[kt2][8 * s + 6], X[kt2][8 * s + 7])};
        bf16x8 pb = *reinterpret_cast<bf16x8*>(&pw);
#pragma unroll
        for (int dt = 0; dt < 2; ++dt) {
          const bf16* vp = sV + (dt * 32 + l31) * TS + kt2 * 32 + s * 16 + lh * 4;
          u32x2 lo = *(const u32x2*)vp, hi = *(const u32x2*)(vp + 8);
          u32x4 vw = {lo[0], lo[1], hi[0], hi[1]};
          bf16x8 va = *reinterpret_cast<bf16x8*>(&vw);
          O[dt] = MFMA32(va, pb, O[dt]);
        }
      }
  }
  l += __shfl_xor(l, 32);
  const float inv = 1.f / l;
#pragma unroll
  for (int r = 0; r < 16; ++r) { O[0][r] *= inv; O[1][r] *= inv; }
}

__device__ __forceinline__ void store_ot(bf16* base  , const f32x16 (&O)[2]) {
  const int tid = otid(); const int lane = tid & 63, w = tid >> 6, l31 = lane & 31, lh = lane >> 5;
  bf16* rowp = base + (size_t)(w * 32 + l31) * DM;
#pragma unroll
  for (int dt = 0; dt < 2; ++dt)
#pragma unroll
    for (int g = 0; g < 4; ++g) { u32x2 wv = {pk_bf16(O[dt][4 * g], O[dt][4 * g + 1]), pk_bf16(O[dt][4 * g + 2], O[dt][4 * g + 3])};
      *(u32x2*)(rowp + dt * 32 + 8 * g + 4 * lh) = wv; }
}

__device__ void diff_item(const Params& p, int layer, int item, char* smem) {
  const int qb = 33 - item / 32, bh = item % 32, b = bh >> 2, h = bh & 3;
  const int tid = otid(), lane = tid & 63, w = tid >> 6, l31 = lane & 31, lh = lane >> 5;
  const bool isctx = qb < 2; const int ntile = (isctx ? CTXL : TPB) >> 6;
  if (isctx && layer == DEPTH - 1) return;
  const size_t qrow0 = (size_t)b * TPB + qb * 128;
  const bf16* K = p.P + (size_t)b * TPB * PW + PC_DK + h * 64; const bf16* Vt = p.DVt + ((size_t)b * 256 + h * 64) * TPB;
  bf16* sK = (bf16*)smem; bf16* sV = sK + 64 * TS;
  bf16x8 qf[2][2];
  { const bf16* qp = p.P + (qrow0 + w * 32 + l31) * PW + PC_DQ + h * 64 + lh * 8;
#pragma unroll
    for (int c = 0; c < 2; ++c)
#pragma unroll
      for (int ks = 0; ks < 2; ++ks) qf[c][ks] = *(const bf16x8*)(qp + c * 32 + ks * 16); }
  float m[2] = {-1e30f, -1e30f}, l[2] = {0.f, 0.f};
  f32x16 O[2][2];
#pragma unroll
  for (int c = 0; c < 2; ++c)
#pragma unroll
    for (int dt = 0; dt < 2; ++dt)
#pragma unroll
      for (int r = 0; r < 16; ++r) O[c][dt][r] = 0.f;
  u32x4 rk[2], rv[2];
  auto gload = [&](int t) { const int key0 = t * 64;
#pragma unroll
    for (int i = 0; i < 2; ++i) { int it = tid + 256 * i; int row = it >> 3, ch = it & 7; rk[i] = *(const u32x4*)(K + (size_t)(key0 + row) * PW + ch * 8); rv[i] = *(const u32x4*)(Vt + (size_t)row * TPB + key0 + ch * 8); } };
  gload(0);
  for (int t = 0; t < ntile; ++t) {
    __syncthreads();
#pragma unroll
    for (int i = 0; i < 2; ++i) { int it = tid + 256 * i; int row = it >> 3, ch = it & 7; *(u32x4*)(sK + row * TS + ch * 8) = rk[i]; *(u32x4*)(sV + row * TS + ch * 8) = rv[i]; }
    __syncthreads();
    if (t + 1 < ntile) gload(t + 1);
    u32x4 pw[2][2][2];
#pragma unroll
    for (int c = 0; c < 2; ++c) {
      f32x16 X[2];
#pragma unroll
      for (int kt2 = 0; kt2 < 2; ++kt2) {
#pragma unroll
        for (int r = 0; r < 16; ++r) X[kt2][r] = 0.f;
#pragma unroll
        for (int ks = 0; ks < 2; ++ks) { bf16x8 a = *(const bf16x8*)(sK + (kt2 * 32 + l31) * TS + c * 32 + ks * 16 + lh * 8); X[kt2] = MFMA32(a, qf[c][ks], X[kt2]); }
      }
      float tmax = X[0][0];
#pragma unroll
      for (int r = 1; r < 16; ++r) tmax = fmaxf(tmax, X[0][r]);
#pragma unroll
      for (int r = 0; r < 16; ++r) tmax = fmaxf(tmax, X[1][r]);
      tmax = fmaxf(tmax, __shfl_xor(tmax, 32));
      if (!__all(tmax <= m[c] + 8.f)) {
        const float mn = fmaxf(m[c], tmax); const float alpha = __builtin_amdgcn_exp2f(m[c] - mn); m[c] = mn; l[c] *= alpha;
#pragma unroll
        for (int r = 0; r < 16; ++r) { O[c][0][r] *= alpha; O[c][1][r] *= alpha; }
      }
      X[0] = X[0] - m[c]; X[1] = X[1] - m[c];
#pragma unroll
      for (int kt2 = 0; kt2 < 2; ++kt2)
#pragma unroll
        for (int r = 0; r < 16; ++r) X[kt2][r] = __builtin_amdgcn_exp2f(X[kt2][r]);
      { const f32x16 sv = X[0] + X[1]; float ps = 0.f;
#pragma unroll
        for (int r = 0; r < 16; ++r) ps += sv[r];
        l[c] += ps; }
#pragma unroll
      for (int kt2 = 0; kt2 < 2; ++kt2)
#pragma unroll
        for (int s2 = 0; s2 < 2; ++s2) {
          u32x4 t4 = {pk_bf16(X[kt2][8 * s2], X[kt2][8 * s2 + 1]), pk_bf16(X[kt2][8 * s2 + 2], X[kt2][8 * s2 + 3]), pk_bf16(X[kt2][8 * s2 + 4], X[kt2][8 * s2 + 5]), pk_bf16(X[kt2][8 * s2 + 6], X[kt2][8 * s2 + 7])};
          pw[c][kt2][s2] = t4; }
    }
#pragma unroll
    for (int kt2 = 0; kt2 < 2; ++kt2)
#pragma unroll
      for (int s2 = 0; s2 < 2; ++s2)
#pragma unroll
        for (int dt = 0; dt < 2; ++dt) {
          const bf16* vp = sV + (dt * 32 + l31) * TS + kt2 * 32 + s2 * 16 + lh * 4;
          u32x2 lo = *(const u32x2*)vp, hi = *(const u32x2*)(vp + 8);
          u32x4 vw = {lo[0], lo[1], hi[0], hi[1]};
          const bf16x8 va = __builtin_bit_cast(bf16x8, vw);
          O[0][dt] = MFMA32(va, __builtin_bit_cast(bf16x8, pw[0][kt2][s2]), O[0][dt]);
          O[1][dt] = MFMA32(va, __builtin_bit_cast(bf16x8, pw[1][kt2][s2]), O[1][dt]);
        }
  }
  const float l0 = l[0] + __shfl_xor(l[0], 32), l1 = l[1] + __shfl_xor(l[1], 32);
  const float lam = p.LAM[layer * 2], li = p.LAM[layer * 2 + 1];
  const float i0 = 1.f / l0, i1 = lam / l1;
  float ss = 0.f;
#pragma unroll
  for (int dt = 0; dt < 2; ++dt)
#pragma unroll
    for (int r = 0; r < 16; ++r) { const float o = O[0][dt][r] * i0 - O[1][dt][r] * i1; O[0][dt][r] = o; ss += o * o; }
  ss += __shfl_xor(ss, 32);
  const float rn = rsqrtf(ss * (1.f / 64.f) + 1e-6f) * (1.f - li);
  const float* g = p.diff_g + layer * 64;
#pragma unroll
  for (int dt = 0; dt < 2; ++dt)
#pragma unroll
    for (int r = 0; r < 16; ++r) O[0][dt][r] *= rn * g[dt * 32 + crow(r, lh)];
  store_ot(p.MIX + qrow0 * DM + 256 + h * 64, O[0]);
}

__device__ void swa_item(const Params& p, int layer, int item, char* smem) {
  const int qb = item / 64, bhh = item % 64, b = bhh >> 3, hh = bhh & 7, g = hh >> 2;
  const bool isctx = qb < 2; const size_t qrow0 = (size_t)b * TPB + qb * 128;
  if (isctx && layer == DEPTH - 1) return;
  const bf16* Kb = p.P + (size_t)b * TPB * PW + PC_SK + g * 64; const bf16* Vt = p.SVt + ((size_t)b * 128 + g * 64) * TPB;
  int s1a = 0, s1b = 0;
  if (!isctx) { const int i = qb - 2; int lo = 128 * (i - 1), hi = 128 * (i + 2); lo = lo < 0 ? 0 : lo; hi = hi > SEQL ? SEQL : hi; s1a = CTXL + lo; s1b = CTXL + hi; }
  f32x16 O[2];
  flash128<64>(p.P + qrow0 * PW + PC_SQ + hh * 64, Kb, Vt, 0, CTXL, s1a, s1b, true, qb * 128, p.sink[layer * 8 + hh] * 1.4426950408889634f, 1.f, O, smem);
  store_ot(p.MIX + qrow0 * DM + 512 + hh * 64, O);
}

enum { PH_PREP = 0, PH_ROW, PH_INPROJ, PH_M1, PH_M2, PH_G3, PH_OUTPROJ, PH_FFNUP, PH_FFNDOWN };
constexpr int N_G1 = NBATCH * 4 * NCHUNK  , N_SWA = 34 * 64  , N_G2 = 256, N_DIFF = 34 * 32  ;

template <int PH> __device__ __forceinline__ int phase_items() {
  return PH == PH_PREP ? PREP_ITEMS : PH == PH_ROW ? TTOK / 16 : PH == PH_INPROJ ? 272 * 21 : PH == PH_M1 ? N_G1 + N_SWA : PH == PH_M2 ? N_G2 + N_DIFF :
         PH == PH_G3 ? N_G1 : PH == PH_OUTPROJ ? 272 * 8 : PH == PH_FFNUP ? 272 * 44 : 272 * 8;
}
template <int PH> __device__ __forceinline__ void run_item(const Params& p, int layer, int sub, int item, char* smem) {
  if (PH == PH_PREP) prep_item(p, item, smem);
  else if (PH == PH_ROW) rowpass_item(p, layer, sub, item);
  else if (PH == PH_M1) { if (item < N_G1) gla_g1_item(p, layer, item, smem); else { __syncthreads(); swa_item(p, layer, item - N_G1, smem); } }
  else if (PH == PH_M2) { if (item < N_G2) gla_g2_item(p, item); else { __syncthreads(); diff_item(p, layer, item - N_G2, smem); } }
  else if (PH == PH_G3) gla_g3_item(p, layer, item, smem);
}
template <int PH> __device__ __forceinline__ void run_phase(const Params& p, int layer, int sub, char* smem) {
  if (PH == PH_INPROJ || PH == PH_OUTPROJ || PH == PH_FFNUP || PH == PH_FFNDOWN) {
    constexpr int NTN = PH == PH_INPROJ ? 21 : (PH == PH_FFNUP ? 44 : 8);
    const int nl = gridDim.x >> 3, xcd = blockIdx.x & 7;
    constexpr int BANDT = (PH == PH_INPROJ || PH == PH_FFNUP) ? 17 : 34;
    for (int q = blockIdx.x >> 3; q < BANDT * NTN; q += nl) {
      if (PH == PH_INPROJ) gemm_item<G_INPROJ>(p, layer, xcd, q, smem);
      else if (PH == PH_OUTPROJ) gemm_item<G_OUTPROJ>(p, layer, xcd, q, smem);
      else if (PH == PH_FFNUP) gemm_item<G_FFNUP>(p, layer, xcd, q, smem);
      else gemm_item<G_FFNDOWN>(p, layer, xcd, q, smem);
    }
    return;
  }
  const int n = phase_items<PH>();
  for (int item = blockIdx.x; item < n; item += gridDim.x) run_item<PH>(p, layer, sub, item, smem);
}

#ifndef B2MASK
#define B2MASK 0x1FF
#endif
template <int PH> __global__ void __launch_bounds__(256, ((B2MASK >> PH) & 1) ? 2 : 1) k_phase(Params p, int layer, int sub) {
  __shared__ __attribute__((aligned(16))) char smem[SMEM_BYTES];
  run_phase<PH>(p, layer, sub, smem);
}

__device__ __forceinline__ void grid_barrier(unsigned* bar, unsigned target) {
  asm volatile("s_waitcnt vmcnt(0)" ::: "memory");
  __syncthreads();
  if (threadIdx.x == 0) {
    __builtin_amdgcn_fence(__ATOMIC_RELEASE, "agent");
    asm volatile("s_waitcnt vmcnt(0)" ::: "memory");
    __hip_atomic_fetch_add(bar, 1u, __ATOMIC_RELAXED, __HIP_MEMORY_SCOPE_AGENT);
    const unsigned long long t0 = __builtin_amdgcn_s_memrealtime();
    while (__hip_atomic_load(bar, __ATOMIC_RELAXED, __HIP_MEMORY_SCOPE_AGENT) < target) {
      __builtin_amdgcn_s_sleep(1);
      if (__builtin_amdgcn_s_memrealtime() - t0 > 200000000ull) { __hip_atomic_store(bar + 32, 1u, __ATOMIC_RELAXED, __HIP_MEMORY_SCOPE_AGENT); break; }
    }
    __builtin_amdgcn_fence(__ATOMIC_ACQUIRE, "agent");
    asm volatile("s_waitcnt vmcnt(0)" ::: "memory");
  }
  __syncthreads();
}
#define GSYNC() do { nbar += 2; grid_barrier(p.BAR, (nbar - 1) * gridDim.x, nbar * gridDim.x); } while (0)
#define XB_TMO      128
#define XB_XCNT(j)  (256  + 64 * (j))
#define XB_XSUB(j)  (1280 + 64 * (j))
#define XB_XGEN(j)  (2304 + 64 * (j))
#define XB_TOP      3328
#define XB_TOPGEN   3392
#define XCD_BAR_WORDS 3456
#define XB_SPIN_CAP (1u << 18)
#define LAS __attribute__((address_space(3)))

__device__ __forceinline__ unsigned xb_ld(unsigned* p)              { return __hip_atomic_load(p, __ATOMIC_RELAXED, __HIP_MEMORY_SCOPE_AGENT); }
__device__ __forceinline__ unsigned xb_add(unsigned* p, unsigned v) { return __hip_atomic_fetch_add(p, v, __ATOMIC_RELAXED, __HIP_MEMORY_SCOPE_AGENT); }
__device__ __forceinline__ unsigned xb_xcc_id() { return (unsigned)__builtin_amdgcn_s_getreg((3 << 11) | 20) & 0xFu; }
#define XB_SPIN(cond, bar) do { unsigned _sp = 0; while (cond) { __builtin_amdgcn_s_sleep(1); \
    if ((++_sp & 255u) == 0u) { if (xb_ld(&(bar)[XB_TMO])) break; if (_sp > XB_SPIN_CAP) { atomicAdd(&(bar)[XB_TMO], 1u); break; } } } } while (0)

struct XcdBarrier {
    unsigned* bar; unsigned x;
    volatile LAS unsigned* st;
};

__device__ __forceinline__ XcdBarrier xcd_barrier_post(unsigned* bar, volatile LAS unsigned* st) {
    XcdBarrier b; b.bar = bar; b.x = xb_xcc_id(); b.st = st;
    if (threadIdx.x == 0) (void)xb_add(&bar[XB_XCNT(b.x)], 1u);
    return b;
}
__device__ __forceinline__ void xcd_barrier_complete(unsigned* bar, unsigned x, unsigned& nloc, unsigned& nx) {
    const unsigned G = gridDim.x * gridDim.y * gridDim.z;
    unsigned sum, cnt, mine, sp = 0u;
    for (;;) {
        sum = 0u; cnt = 0u; mine = 0u;
#pragma unroll
        for (unsigned j = 0; j < 16; ++j) { const unsigned c = xb_ld(&bar[XB_XCNT(j)]); sum += c; cnt += (c > 0u) ? 1u : 0u; mine = (j == x) ? c : mine; }
        if (sum == G) break;
        __builtin_amdgcn_s_sleep(1);
        if ((++sp & 255u) == 0u) { if (xb_ld(&bar[XB_TMO])) break; if (sp > XB_SPIN_CAP) { atomicAdd(&bar[XB_TMO], 1u); break; } }
    }
    nloc = mine > 0u ? mine : 1u; nx = cnt > 0u ? cnt : 1u;
}

__device__ __forceinline__ void xcd_barrier(const XcdBarrier& b) {
    asm volatile("s_waitcnt vmcnt(0)" ::: "memory");
    __syncthreads();
    if (threadIdx.x == 0) {
        unsigned* bar = b.bar;
        __builtin_amdgcn_s_waitcnt(0);
        unsigned nloc = b.st[0], nx = b.st[1];
        if (nloc == 0u) { xcd_barrier_complete(bar, b.x, nloc, nx); b.st[0] = nloc; b.st[1] = nx; }
        const unsigned old = xb_add(&bar[XB_XSUB(b.x)], 1u);
        const unsigned gen = old / nloc;
        if (old + 1u == (gen + 1u) * nloc) {
            __builtin_amdgcn_fence(__ATOMIC_RELEASE, "agent");
            asm volatile("s_waitcnt vmcnt(0)" ::: "memory");
            const unsigned og = xb_add(&bar[XB_TOP], 1u);
            const unsigned tg = og / nx;
            if (og + 1u == (tg + 1u) * nx) xb_add(&bar[XB_TOPGEN], 1u);
            else XB_SPIN(xb_ld(&bar[XB_TOPGEN]) == tg, bar);
            __builtin_amdgcn_fence(__ATOMIC_ACQUIRE, "agent");
            xb_add(&bar[XB_XGEN(b.x)], 1u);
            asm volatile("s_waitcnt vmcnt(0)" ::: "memory");
        } else {
            XB_SPIN(xb_ld(&bar[XB_XGEN(b.x)]) == gen, bar);
            __builtin_amdgcn_fence(__ATOMIC_ACQUIRE, "agent");
            asm volatile("s_waitcnt vmcnt(0)" ::: "memory");
        }
    }
    __syncthreads();
}

__device__ __forceinline__ void run_program_phase(const Params& p, int ph, char* smem) {
  if (ph == 0) { run_phase<PH_PREP>(p, 0, 0, smem); return; }
  if (ph == 37) { run_phase<PH_ROW>(p, DEPTH, 0, smem); return; }
  const int layer = (ph - 1) / 9, k = (ph - 1) % 9;
  switch (k) {
    case 0: run_phase<PH_ROW>(p, layer, 0, smem); break;
    case 1: run_phase<PH_INPROJ>(p, layer, 0, smem); break;
    case 2: run_phase<PH_M1>(p, layer, 0, smem); break;
    case 3: run_phase<PH_M2>(p, layer, 0, smem); break;
    case 4: run_phase<PH_G3>(p, layer, 0, smem); break;
    case 5: run_phase<PH_OUTPROJ>(p, layer, 0, smem); break;
    case 6: run_phase<PH_ROW>(p, layer, 1, smem); break;
    case 7: run_phase<PH_FFNUP>(p, layer, 0, smem); break;
    default: run_phase<PH_FFNDOWN>(p, layer, 0, smem); break;
  }
}
__global__ void __launch_bounds__(256, 2) k_mega(Params p, int ph_lo, int ph_hi, int bar_slot) {
  __shared__ __attribute__((aligned(16))) char smem[SMEM_BYTES];
#if COOP
  if (ph_lo < 0) cg::this_grid().sync();
#endif
  unsigned nbar = 0;
  unsigned* bar = p.BAR + bar_slot * 64;
  (void)nbar; (void)bar;
  volatile LAS unsigned* xst = (volatile LAS unsigned*)(smem + SMEM_BYTES - 16);
  if (threadIdx.x == 0) { xst[0] = 0u; xst[1] = 0u; }
  __syncthreads();
  XcdBarrier xb = xcd_barrier_post(p.BAR, xst);
#pragma unroll 1
  for (int ph = ph_lo; ph < ph_hi; ++ph) {
    run_program_phase(p, ph, smem);
#ifdef REPEAT_MASK
    if (ph >= 1 && ph < 37 && ((REPEAT_MASK >> ((ph - 1) % 9)) & 1)) { ++nbar; grid_barrier(bar, nbar * gridDim.x); run_program_phase(p, ph, smem); }
#endif
    if (ph + 1 < ph_hi) xcd_barrier(xb);
#ifdef DOUBLE_BAR
    if (ph + 1 < ph_hi) xcd_barrier(xb);
#endif
  }
}

extern "C" void kernel_launch(void* const* d_in, const int* in_sizes, int n_in, void* d_out, int out_size, void* d_ws, size_t ws_size, hipStream_t stream) {
  Params p{};
  p.x = (const float*)d_in[0]; p.c = (const float*)d_in[1]; p.ctx = (const float*)d_in[2]; p.c_ctx = (const float*)d_in[3];
  p.w_ada = (const float*)d_in[4]; p.b_ada = (const float*)d_in[5]; p.w_in = (const float*)d_in[6]; p.w_gg = (const float*)d_in[7]; p.b_gg = (const float*)d_in[8];
  p.gla_g = (const float*)d_in[9]; p.dlam = (const float*)d_in[10]; p.diff_g = (const float*)d_in[11]; p.sink = (const float*)d_in[12]; p.w_out = (const float*)d_in[13];
  p.ln_g = (const float*)d_in[14]; p.ln_b = (const float*)d_in[15]; p.w_fg = (const float*)d_in[16]; p.w_fu = (const float*)d_in[17]; p.w_fd = (const float*)d_in[18];
  p.out = (float*)d_out;
  char* ws = (char*)d_ws; size_t off = 0;
  auto take = [&](size_t bytes) { char* r = ws + off; off += (bytes + 255) & ~(size_t)255; return r; };
  p.Z = (float*)take((size_t)TTOK * DM * 4);
  p.MIX = (bf16*)take((size_t)TTOK * DM * 2);
  p.P = (bf16*)take((size_t)TTOK * PW * 2);
  p.HID = p.MIX;
  p.GVt = (bf16*)take((size_t)NBATCH * 256 * TPB * 2);
  p.DVt = (bf16*)take((size_t)NBATCH * 256 * TPB * 2);
  p.SVt = (bf16*)take((size_t)NBATCH * 128 * TPB * 2);
  p.GZ = (float*)take((size_t)TTOK * 32 * 4);
  p.U = (bf16*)take((size_t)TTOK * DM * 2);
  p.SlocT = (float*)p.U;
  p.Sprev = (bf16*)take((size_t)64 * NCHUNK * 4096 * 2);
  p.MOD = (float*)take((size_t)DEPTH * 9 * 6144 * 4);
  p.ST = (float*)take((size_t)TTOK * 2 * 4);
  p.DEC = (float*)take((size_t)64 * NCHUNK * 64 * 4);
  p.TAB32 = (float*)take(64 * 8 * 2 * 4);
  p.TAB64 = (float*)take(64 * 16 * 2 * 4);
  p.LAM = (float*)take(256);
  p.BAR = (unsigned*)take(16384);
  if (off > ws_size) { fprintf(stderr, "workspace too small: need %zu have %zu\n", off, ws_size); return; }
  { char* o = (char*)d_out; size_t oo = 0;
    p.WinT = (bf16*)(o + oo); oo += (size_t)DEPTH * WIN_ROWS * DM * 2;
    p.WoT = (bf16*)(o + oo); oo += (size_t)DEPTH * DM * DM * 2;
    p.WguT = (bf16*)(o + oo); oo += (size_t)DEPTH * 5632 * DM * 2;
    p.WdT = (bf16*)(o + oo); oo += (size_t)DEPTH * DM * FFNH * 2; }
#if MEGA
  static int grid_blocks = 0;
  if (!grid_blocks) { int dev = 0, cus = 0, per_cu = 0; (void)hipGetDevice(&dev); (void)hipDeviceGetAttribute(&cus, hipDeviceAttributeMultiprocessorCount, dev);
    (void)hipOccupancyMaxActiveBlocksPerMultiprocessor(&per_cu, k_mega, 256, 0); if (per_cu > 2) per_cu = 2; if (per_cu < 1) per_cu = 1; grid_blocks = (cus * per_cu) & ~7; if (grid_blocks < 8) grid_blocks = 8; }
  (void)hipMemsetAsync(p.BAR, 0, 16384, stream);
  int cuts[48]; int ncut = 0; cuts[ncut++] = 0;
  if (!((FUSE >> 9) & 1)) cuts[ncut++] = 1;
  for (int ph = 1; ph < 37; ++ph) { const int k = (ph - 1) % 9; if (!((FUSE >> k) & 1)) cuts[ncut++] = ph + 1; }
  cuts[ncut++] = 38;
  for (int i = 0; i + 1 < ncut; ++i) if (cuts[i + 1] > cuts[i]) {
#if COOP
    int lo = cuts[i], hi = cuts[i + 1], slot = i; void* args[] = {&p, &lo, &hi, &slot};
    hipError_t e = hipLaunchCooperativeKernel((void*)k_mega, dim3(grid_blocks), dim3(256), args, 0, stream);
    if (e != hipSuccess) fprintf(stderr, "cooperative launch failed: %s (grid %d)\n", hipGetErrorString(e), grid_blocks);
#else
    k_mega<<<grid_blocks, 256, 0, stream>>>(p, cuts[i], cuts[i + 1], i);
#endif
  }
#else
  const int G = 2048;
  k_phase<PH_PREP><<<G, 256, 0, stream>>>(p, 0, 0);
  for (int layer = 0; layer < DEPTH; ++layer) {
    k_phase<PH_ROW><<<G, 256, 0, stream>>>(p, layer, 0);
    k_phase<PH_INPROJ><<<G, 256, 0, stream>>>(p, layer, 0);
    k_phase<PH_M1><<<G, 256, 0, stream>>>(p, layer, 0);
    k_phase<PH_M2><<<G, 256, 0, stream>>>(p, layer, 0);
    k_phase<PH_G3><<<G, 256, 0, stream>>>(p, layer, 0);
    k_phase<PH_OUTPROJ><<<G, 256, 0, stream>>>(p, layer, 0);
    k_phase<PH_ROW><<<G, 256, 0, stream>>>(p, layer, 1);
    k_phase<PH_FFNUP><<<G, 256, 0, stream>>>(p, layer, 0);
    k_phase<PH_FFNDOWN><<<G, 256, 0, stream>>>(p, layer, 0);
  }
  k_phase<PH_ROW><<<G, 256, 0, stream>>>(p, DEPTH, 0);
#endif
}
```

```cpp
#include <hip/hip_runtime.h>
#include <hip/hip_cooperative_groups.h>
#include <stdint.h>
#include <stdio.h>
namespace cg = cooperative_groups;

#ifndef COOP
#define COOP 1
#endif
#ifndef DELAY_ITERS
#define DELAY_ITERS 0
#endif
#ifndef FUSE
#define FUSE 0x3FF
#endif
#ifndef MEGA
#define MEGA 1
#endif

typedef unsigned short bf16;
typedef __attribute__((ext_vector_type(8))) short bf16x8;
typedef __attribute__((ext_vector_type(4))) short bf16x4;
typedef __attribute__((ext_vector_type(16))) float f32x16;
typedef __attribute__((ext_vector_type(4))) float f32x4;
typedef __attribute__((ext_vector_type(4))) unsigned u32x4;
typedef __attribute__((ext_vector_type(2))) unsigned u32x2;

constexpr int DM = 1024, NBATCH = 8, SEQL = 4096, CTXL = 256, TPB = 4352, TTOK = 34816, DEPTH = 4, FFNH = 2816;
constexpr int NCHUNK = 68;
constexpr int PW = 1920;
constexpr int PC_GQ = 0, PC_GK = 256, PC_GO = 512, PC_DQ = 768, PC_DK = 1024, PC_SQ = 1280, PC_SK = 1792;
constexpr int WIN_ROWS = 2688;
constexpr float DN_ALPHA = 1.6817928305074292f;
constexpr int SMEM_BYTES = 61440;

struct Params {
  const float *x, *c, *ctx, *c_ctx, *w_ada, *b_ada, *w_in, *w_gg, *b_gg, *gla_g, *dlam, *diff_g, *sink, *w_out, *ln_g, *ln_b, *w_fg, *w_fu, *w_fd;
  float* out;
  float* Z; bf16* U; bf16* MIX; bf16* P; bf16* GVt; bf16* DVt; bf16* SVt; float* GZ; bf16* HID;
  float* SlocT; bf16* Sprev; float* DEC; float* MOD; float* ST; float* TAB32; float* TAB64; float* LAM; unsigned* BAR;
  bf16 *WinT, *WoT, *WguT, *WdT;
};

typedef float f32x2v __attribute__((ext_vector_type(2)));
typedef __bf16 bf16x2v __attribute__((ext_vector_type(2)));
__device__ __forceinline__ unsigned pk_bf16(float lo, float hi) { f32x2v f = {lo, hi}; bf16x2v b = __builtin_convertvector(f, bf16x2v); return __builtin_bit_cast(unsigned, b); }
__device__ __forceinline__ bf16 f2bf(float x) { return (bf16)(pk_bf16(x, 0.f) & 0xffffu); }
__device__ __forceinline__ float bf2f(unsigned short x) { return __uint_as_float(((unsigned)x) << 16); }
__device__ __forceinline__ float bflo(unsigned w) { return __uint_as_float(w << 16); }
__device__ __forceinline__ float bfhi(unsigned w) { return __uint_as_float(w & 0xffff0000u); }
__device__ __forceinline__ int crow(int r, int hi) { return (r & 3) + 8 * (r >> 2) + 4 * hi; }
__device__ __forceinline__ float wave_sum(float v) {
#pragma unroll
  for (int o = 32; o >= 1; o >>= 1) v += __shfl_xor(v, o);
  return v;
}
__device__ __forceinline__ int otid() { int t = threadIdx.x; asm volatile("" : "+v"(t)); return t; }
#define MFMA32(a, b, c) __builtin_amdgcn_mfma_f32_32x32x16_bf16((a), (b), (c), 0, 0, 0)

constexpr int PREP_T_PER_LAYER = 3016, PREP_T = 4 * PREP_T_PER_LAYER, PREP_MOD = 384, PREP_ITEMS = PREP_T + PREP_MOD + 1;

__device__ void transpose_tile(const float* src, int N, bf16* dst, int ldd, int n0, int k0, int drow0, char* smem) {
  float* tile = (float*)smem;
  const int tid = otid();
#pragma unroll
  for (int i = 0; i < 4; ++i) { const int k = (tid >> 3) + 32 * i, n4 = (tid & 7) * 4; const f32x4 v = *(const f32x4*)(src + (size_t)(k0 + k) * N + n0 + n4);
    tile[k * 33 + n4] = v[0]; tile[k * 33 + n4 + 1] = v[1]; tile[k * 33 + n4 + 2] = v[2]; tile[k * 33 + n4 + 3] = v[3]; }
  __syncthreads();
#pragma unroll
  for (int u = 0; u < 2; ++u) { const int it = tid + 256 * u; const int n = it >> 4, kg = it & 15; float v[8];
#pragma unroll
    for (int e = 0; e < 8; ++e) v[e] = tile[(kg * 8 + e) * 33 + n];
    u32x4 w = {pk_bf16(v[0], v[1]), pk_bf16(v[2], v[3]), pk_bf16(v[4], v[5]), pk_bf16(v[6], v[7])};
    *(u32x4*)(dst + (size_t)(drow0 + n) * ldd + k0 + kg * 8) = w; }
  __syncthreads();
}

__device__ void prep_item(const Params& p, int item0, char* smem) {
  const int tid = otid();
  const int item = item0 < PREP_MOD ? PREP_T + item0 : (item0 < PREP_MOD + PREP_T ? item0 - PREP_MOD : item0);
  if (item < PREP_T) {
    int l = item / PREP_T_PER_LAYER, ti = item % PREP_T_PER_LAYER;
    if (ti < 648) { int nt = ti / 8, kt = ti % 8; int n0 = nt * 32; int dr = n0 < 1024 ? n0 : (n0 < 1056 ? 2560 + (n0 - 1024) : n0 - 32);
      transpose_tile(p.w_in + (size_t)l * 1024 * 2592, 2592, p.WinT + (size_t)l * WIN_ROWS * 1024, 1024, n0, kt * 128, dr, smem); }
    else if (ti < 904) { ti -= 648; int nt = ti / 8, kt = ti % 8;
      transpose_tile(p.w_out + (size_t)l * 1024 * 1024, 1024, p.WoT + (size_t)l * 1024 * 1024, 1024, nt * 32, kt * 128, nt * 32, smem); }
    else if (ti < 1608) { ti -= 904; int nt = ti / 8, kt = ti % 8;
      transpose_tile(p.w_fg + (size_t)l * 1024 * FFNH, FFNH, p.WguT + (size_t)l * 5632 * 1024, 1024, nt * 32, kt * 128, nt * 64, smem); }
    else if (ti < 2312) { ti -= 1608; int nt = ti / 8, kt = ti % 8;
      transpose_tile(p.w_fu + (size_t)l * 1024 * FFNH, FFNH, p.WguT + (size_t)l * 5632 * 1024, 1024, nt * 32, kt * 128, nt * 64 + 32, smem); }
    else { ti -= 2312; int nt = ti / 22, kt = ti % 22;
      transpose_tile(p.w_fd + (size_t)l * FFNH * 1024, 1024, p.WdT + (size_t)l * 1024 * FFNH, FFNH, nt * 32, kt * 128, nt * 32, smem); }
  } else if (item < PREP_T + PREP_MOD) {
    int mi = item - PREP_T; int l = mi / 96, cb = mi % 96;
    float* sv = (float*)smem;
    float* red = sv + 9 * 1024;
    for (int idx = tid; idx < 9216; idx += 256) { int m = idx >> 10, k = idx & 1023; float v = m < 8 ? p.c[m * 1024 + k] : p.c_ctx[k]; sv[idx] = v / (1.f + expf(-v)); }
    __syncthreads();
    int kp = tid >> 6, col = tid & 63; float acc[9];
#pragma unroll
    for (int m = 0; m < 9; ++m) acc[m] = 0.f;
    const float* wp = p.w_ada + ((size_t)l * 1024 + kp * 256) * 6144 + cb * 64 + col;
#pragma unroll 16
    for (int k = 0; k < 256; ++k) { float wv = wp[(size_t)k * 6144];
#pragma unroll
      for (int m = 0; m < 9; ++m) acc[m] += sv[m * 1024 + kp * 256 + k] * wv; }
#pragma unroll
    for (int m = 0; m < 9; ++m) red[(kp * 9 + m) * 64 + col] = acc[m];
    __syncthreads();
    for (int idx = tid; idx < 576; idx += 256) { int m = idx >> 6, cc = idx & 63;
      float s = red[(0 * 9 + m) * 64 + cc] + red[(1 * 9 + m) * 64 + cc] + red[(2 * 9 + m) * 64 + cc] + red[(3 * 9 + m) * 64 + cc] + p.b_ada[l * 6144 + cb * 64 + cc];
      p.MOD[((size_t)l * 9 + m) * 6144 + cb * 64 + cc] = s; }
    __syncthreads();
  } else {
    if (tid < 64) { int pos = tid;
      for (int f = 0; f < 8; ++f) { float inv = exp2f(-(float)f / 8.f * 13.287712379549449f); float a = (float)pos * inv; p.TAB32[(pos * 8 + f) * 2] = cosf(a); p.TAB32[(pos * 8 + f) * 2 + 1] = sinf(a); }
      for (int f = 0; f < 16; ++f) { float inv = exp2f(-(float)f / 16.f * 13.287712379549449f); float a = (float)pos * inv; p.TAB64[(pos * 16 + f) * 2] = cosf(a); p.TAB64[(pos * 16 + f) * 2 + 1] = sinf(a); }
    }
    if (tid >= 64 && tid < 68) { int l = tid - 64; const float* d = p.dlam + l * 128; float s1 = 0.f, s2 = 0.f;
      for (int i = 0; i < 32; ++i) { s1 += d[i] * d[32 + i]; s2 += d[64 + i] * d[96 + i]; }
      float li = 0.8f - 0.6f * expf(-0.3f * (float)l);
      p.LAM[l * 2] = expf(s1) - expf(s2) + li; p.LAM[l * 2 + 1] = li; }
  }
}

__device__ void rowpass_row(const Params& p, int layer, int sub, int row, int lane) {
  const int b = row / TPB, tin = row % TPB; const bool isctx = tin < CTXL;
  const bool first = (layer == 0 && sub == 0);
  if (layer == DEPTH - 1 && sub == 1 && isctx) return;
  const float* src = first ? (isctx ? p.ctx + ((size_t)b * CTXL + tin) * DM : p.x + ((size_t)b * SEQL + (tin - CTXL)) * DM) : p.Z + (size_t)row * DM;
  f32x4 v[4];
#pragma unroll
  for (int i = 0; i < 4; ++i) v[i] = *(const f32x4*)(src + (i >> 1) * 512 + lane * 8 + (i & 1) * 4);
  if (!first) {
    float s = 0.f;
#pragma unroll
    for (int i = 0; i < 4; ++i) s += (v[i][0] + v[i][1]) + (v[i][2] + v[i][3]);
    const float mean = wave_sum(s) * (1.f / 1024.f);
    float q = 0.f;
#pragma unroll
    for (int i = 0; i < 4; ++i) { f32x4 d = v[i] - mean; q += (d[0] * d[0] + d[1] * d[1]) + (d[2] * d[2] + d[3] * d[3]); }
    const float rstd = rsqrtf(wave_sum(q) * (1.f / 1024.f) + 1e-6f);
    if (lane == 0) { p.ST[row * 2] = mean; p.ST[row * 2 + 1] = rstd; }
    const int gl = sub == 0 ? (layer - 1) * 2 + 1 : layer * 2;
    const float* g = p.ln_g + (size_t)gl * DM; const float* bb = p.ln_b + (size_t)gl * DM;
#pragma unroll
    for (int i = 0; i < 4; ++i) { f32x4 gv = *(const f32x4*)(g + (i >> 1) * 512 + lane * 8 + (i & 1) * 4), bv = *(const f32x4*)(bb + (i >> 1) * 512 + lane * 8 + (i & 1) * 4); v[i] = (v[i] - mean) * rstd * gv + bv; }
  } else {
    if (lane == 0) { p.ST[row * 2] = 0.f; p.ST[row * 2 + 1] = 1.f; }
#pragma unroll
    for (int i = 0; i < 4; ++i) *(f32x4*)(p.Z + (size_t)row * DM + (i >> 1) * 512 + lane * 8 + (i & 1) * 4) = v[i];
  }
  if (layer == DEPTH) {
    float fac = 1.f;
#if MEGA
#endif
    if (!isctx) { float* o = p.out + ((size_t)b * SEQL + (tin - CTXL)) * DM;
#pragma unroll
      for (int i = 0; i < 4; ++i) *(f32x4*)(o + (i >> 1) * 512 + lane * 8 + (i & 1) * 4) = v[i] * fac; }
    return;
  }
  float s = 0.f;
#pragma unroll
  for (int i = 0; i < 4; ++i) s += (v[i][0] + v[i][1]) + (v[i][2] + v[i][3]);
  const float mean2 = wave_sum(s) * (1.f / 1024.f);
  float q = 0.f;
#pragma unroll
  for (int i = 0; i < 4; ++i) { f32x4 d = v[i] - mean2; q += (d[0] * d[0] + d[1] * d[1]) + (d[2] * d[2] + d[3] * d[3]); }
  const float rstd2 = rsqrtf(wave_sum(q) * (1.f / 1024.f) + 1e-6f);
  const int msel = isctx ? 8 : b;
  const float* md = p.MOD + ((size_t)layer * 9 + msel) * 6144;
  const float* sh = md + (sub ? 3 : 0) * DM; const float* sc = md + (sub ? 4 : 1) * DM;
#pragma unroll
  for (int i2 = 0; i2 < 2; ++i2) { unsigned w4[4];
#pragma unroll
    for (int h = 0; h < 2; ++h) { const int i = i2 * 2 + h; const int co = i2 * 512 + lane * 8 + h * 4;
      f32x4 shv = *(const f32x4*)(sh + co), scv = *(const f32x4*)(sc + co);
      f32x4 u = (v[i] - mean2) * rstd2 * (scv + 1.f) + shv;
      w4[h * 2] = pk_bf16(u[0], u[1]); w4[h * 2 + 1] = pk_bf16(u[2], u[3]); }
    u32x4 wv = {w4[0], w4[1], w4[2], w4[3]};
    *(u32x4*)(p.U + (size_t)row * DM + i2 * 512 + lane * 8) = wv; }
}

__device__ void rowpass_item(const Params& p, int layer, int sub, int item) {
  const int tid = otid(); const int w = tid >> 6, lane = tid & 63;
#pragma unroll
  for (int i = 0; i < 4; ++i) rowpass_row(p, layer, sub, item * 16 + w * 4 + i, lane);
}

constexpr int GLS = 40;
enum { G_INPROJ = 0, G_OUTPROJ = 1, G_FFNUP = 2, G_FFNDOWN = 3 };

template <int MODE>
__device__ void gemm_item(const Params& p, int layer, int xcd, int q, char* smem) {
  constexpr int NTN = MODE == G_INPROJ ? 21 : (MODE == G_FFNUP ? 44 : 8);
  constexpr int K = MODE == G_FFNDOWN ? FFNH : DM;
  constexpr int BM = (MODE == G_INPROJ || MODE == G_FFNUP) ? 256 : 128;
  constexpr int MI = BM / 64, BAND = 4352 / BM, STRIP = BAND * 8;
  constexpr int NS = NTN / 8, REM = NTN % 8;
  const int sidx = q / STRIP; const int sw = sidx < NS ? 8 : REM; const int base = (sidx < NS ? sidx : NS) * STRIP; const int c0 = (sidx < NS ? sidx : NS) * 8;
  const int mt = BAND * xcd + (q - base) / sw, nt = c0 + (q - base) % sw; const int m0 = mt * BM, n0 = nt * 128;
  if (MODE != G_INPROJ && layer == DEPTH - 1 && (m0 % TPB) < CTXL) return;
  const bf16* A; const bf16* Bt; int lda = K, ldb = K;
  if (MODE == G_INPROJ) { A = p.U; Bt = p.WinT + (size_t)layer * WIN_ROWS * DM; }
  else if (MODE == G_OUTPROJ) { A = p.MIX; Bt = p.WoT + (size_t)layer * DM * DM; }
  else if (MODE == G_FFNUP) { A = p.U; Bt = p.WguT + (size_t)layer * 5632 * DM; }
  else { A = p.HID; Bt = p.WdT + (size_t)layer * DM * FFNH; }
  const int tid = otid(), lane = tid & 63, w = tid >> 6, wm = w >> 1, wn = w & 1, l31 = lane & 31, lh = lane >> 5;
  constexpr int BK = 64, LS = 72, NA = BM / 32;
  bf16* sA = (bf16*)smem; bf16* sB = sA + BM * LS;
  const int r0 = tid >> 3, kc = (tid & 7) * 8;
  const bf16* a0 = A + (size_t)(m0 + r0) * lda + kc; const bf16* b0 = Bt + (size_t)(n0 + r0) * ldb + kc;
  const size_t a32 = (size_t)32 * lda, b32 = (size_t)32 * ldb;
  const int so0 = r0 * LS + kc;
  u32x4 sa[NA], sb[4];
#define G_LOAD(KT) do { const int ko_ = (KT) * BK; _Pragma("unroll") for (int u = 0; u < NA; ++u) sa[u] = *(const u32x4*)(a0 + u * a32 + ko_); _Pragma("unroll") for (int u = 0; u < 4; ++u) sb[u] = *(const u32x4*)(b0 + u * b32 + ko_); } while (0)
#define G_STORE() do { _Pragma("unroll") for (int u = 0; u < NA; ++u) *(u32x4*)(sA + so0 + u * 32 * LS) = sa[u]; _Pragma("unroll") for (int u = 0; u < 4; ++u) *(u32x4*)(sB + so0 + u * 32 * LS) = sb[u]; } while (0)
#define G_COMPUTE() do { const bf16* cA = sA + (wm * (BM / 2) + l31) * LS + lh * 8; const bf16* cB = sB + (wn * 64 + l31) * LS + lh * 8; \
    _Pragma("unroll") for (int ks = 0; ks < 4; ++ks) { bf16x8 af[MI], bfr[2]; \
      _Pragma("unroll") for (int i = 0; i < MI; ++i) af[i] = *(const bf16x8*)(cA + i * 32 * LS + ks * 16); \
      _Pragma("unroll") for (int jj = 0; jj < 2; ++jj) bfr[jj] = *(const bf16x8*)(cB + jj * 32 * LS + ks * 16); \
      _Pragma("unroll") for (int i = 0; i < MI; ++i) _Pragma("unroll") for (int jj = 0; jj < 2; ++jj) acc[i][jj] = MFMA32(af[i], bfr[jj], acc[i][jj]); } } while (0)
  f32x16 acc[MI][2];
#pragma unroll
  for (int i = 0; i < MI; ++i)
#pragma unroll
    for (int jj = 0; jj < 2; ++jj)
#pragma unroll
      for (int r = 0; r < 16; ++r) acc[i][jj][r] = 0.f;
  constexpr int NK = K / BK;
  G_LOAD(0);
  G_STORE();
  __syncthreads();
#pragma unroll 1
  for (int kt = 0; kt < NK; ++kt) {
    G_LOAD((kt + 1 < NK ? kt + 1 : NK - 1));
    asm volatile("" ::: "memory");
    G_COMPUTE();
    __syncthreads();
    G_STORE();
    __syncthreads();
  }
#undef G_LOAD
#undef G_STORE
#undef G_COMPUTE
  const int bidx = m0 / TPB, tin0 = m0 % TPB; const bool ctxtile = tin0 < CTXL; const int msel = ctxtile ? 8 : bidx;
  if (MODE == G_OUTPROJ || MODE == G_FFNDOWN) {
    const float* gate = p.MOD + ((size_t)layer * 9 + msel) * 6144 + (MODE == G_OUTPROJ ? 2 : 5) * DM;
    const bool haveln = !(MODE == G_OUTPROJ && layer == 0);
    const int gl = MODE == G_OUTPROJ ? (layer - 1) * 2 + 1 : layer * 2;
    const float* g = p.ln_g + (size_t)(haveln ? gl : 0) * DM; const float* bb = p.ln_b + (size_t)(haveln ? gl : 0) * DM;
    const int col0 = n0 + wn * 64 + l31;
    const float gt0 = gate[col0], gt1 = gate[col0 + 32];
    const float gv0 = haveln ? g[col0] : 1.f, gv1 = haveln ? g[col0 + 32] : 1.f, bv0 = haveln ? bb[col0] : 0.f, bv1 = haveln ? bb[col0 + 32] : 0.f;
#pragma unroll
    for (int i = 0; i < MI; ++i)
#pragma unroll
      for (int r = 0; r < 16; ++r) {
        const int row = m0 + wm * (BM / 2) + i * 32 + crow(r, lh);
        float* zp = p.Z + (size_t)row * DM + col0;
        const float mean = p.ST[row * 2], rstd = p.ST[row * 2 + 1];
        const float h0 = (zp[0] - mean) * rstd * gv0 + bv0, h1 = (zp[32] - mean) * rstd * gv1 + bv1;
        zp[0] = DN_ALPHA * h0 + gt0 * acc[i][0][r];
        zp[32] = DN_ALPHA * h1 + gt1 * acc[i][1][r];
        if (r == 15) asm volatile("" ::: "memory");
      }
  } else if (MODE == G_FFNUP) {
    bf16* sH = (bf16*)smem;
#pragma unroll
    for (int i = 0; i < MI; ++i)
#pragma unroll
      for (int r = 0; r < 16; ++r) {
        const float gg = acc[i][0][r], uu = acc[i][1][r];
        const float hv = gg * __builtin_amdgcn_rcpf(1.f + __expf(-gg)) * uu;
        sH[(wm * (BM / 2) + i * 32 + crow(r, lh)) * 72 + wn * 32 + l31] = f2bf(hv);
      }
    __syncthreads();
#pragma unroll
    for (int u = 0; u < BM / 32; ++u) { const int it = tid + 256 * u; const int row = it >> 3, ch = it & 7;
      *(u32x4*)(p.HID + (size_t)(m0 + row) * FFNH + n0 / 2 + ch * 8) = *(const u32x4*)(sH + row * 72 + ch * 8); }
    __syncthreads();
  } else {
    float* sC = (float*)smem;
    int mode, dcol = 0; float scale = 1.f; bf16* xt = nullptr; int xcols = 0, xcb = 0;
    if (nt < 2) { mode = 0; scale = 0.125f; dcol = PC_GQ + nt * 128; }
    else if (nt < 4) { mode = 0; dcol = PC_GK + (nt - 2) * 128; }
    else if (nt < 6) { mode = 3; xt = p.GVt; xcols = 256; xcb = (nt - 4) * 128; }
    else if (nt < 8) { mode = 0; dcol = PC_GO + (nt - 6) * 128; }
    else if (nt < 10) { mode = 1; scale = 0.17677669529663687f * 1.4426950408889634f; dcol = PC_DQ + (nt - 8) * 128; }
    else if (nt < 12) { mode = 1; dcol = PC_DK + (nt - 10) * 128; }
    else if (nt < 14) { mode = 3; xt = p.DVt; xcols = 256; xcb = (nt - 12) * 128; }
    else if (nt < 18) { mode = 2; scale = 0.125f * 1.4426950408889634f; dcol = PC_SQ + (nt - 14) * 128; }
    else if (nt < 19) { mode = 2; dcol = PC_SK; }
    else if (nt < 20) { mode = 3; xt = p.SVt; xcols = 128; xcb = 0; }
    else mode = 4;
    const int cs = mode == 3 ? 133 : 132;
#pragma unroll
    for (int half = 0; half < BM / 64; ++half) {
      if (wm == half / (MI / 2)) {
#pragma unroll
        for (int i = 0; i < 2; ++i)
#pragma unroll
          for (int j = 0; j < 2; ++j)
#pragma unroll
            for (int r = 0; r < 16; ++r) sC[(i * 32 + crow(r, lh)) * cs + wn * 64 + j * 32 + l31] = acc[(half % (MI / 2)) * 2 + i][j][r];
      }
      __syncthreads();
      if (mode <= 2) {
        for (int it = tid; it < 1024; it += 256) {
          const int row = it >> 4, cg8 = (it & 15) * 8; const int tin = tin0 + half * 64 + row; const size_t token = (size_t)m0 + half * 64 + row;
          float v[8];
          { const f32x4 v0 = *(const f32x4*)(sC + row * cs + cg8), v1 = *(const f32x4*)(sC + row * cs + cg8 + 4);
#pragma unroll
            for (int e = 0; e < 4; ++e) { v[e] = v0[e]; v[4 + e] = v1[e]; } }
          if (mode != 0 && !ctxtile) {
            const int dimh = mode == 1 ? 16 : 32; const int d = cg8 & (2 * dimh - 1); const bool second = d >= dimh; const int pi0 = second ? d - dimh : d;
            const int pcol = second ? cg8 - dimh : cg8 + dimh; const int nf = dimh >> 1; const bool usecol = pi0 >= nf; const int f0 = usecol ? pi0 - nf : pi0;
            const int pos = tin - CTXL; const int ps = usecol ? (pos & 63) : (pos >> 6);
            const float* tb = (mode == 1 ? p.TAB32 + (ps * 8 + f0) * 2 : p.TAB64 + (ps * 16 + f0) * 2);
            const f32x4 w0 = *(const f32x4*)(sC + row * cs + pcol), w1 = *(const f32x4*)(sC + row * cs + pcol + 4);
#pragma unroll
            for (int e2 = 0; e2 < 4; ++e2) { const f32x4 t4 = *(const f32x4*)(tb + e2 * 4);
#pragma unroll
              for (int h2 = 0; h2 < 2; ++h2) { const int e = e2 * 2 + h2; const float wv = e < 4 ? w0[e & 3] : w1[e & 3]; const float co = t4[h2 * 2], sn = t4[h2 * 2 + 1];
                v[e] = second ? (wv * sn + v[e] * co) : (v[e] * co - wv * sn); } }
          }
          u32x4 wv = {pk_bf16(v[0] * scale, v[1] * scale), pk_bf16(v[2] * scale, v[3] * scale), pk_bf16(v[4] * scale, v[5] * scale), pk_bf16(v[6] * scale, v[7] * scale)};
          *(u32x4*)(p.P + token * PW + dcol + cg8) = wv;
        }
      } else if (mode == 3) {
        for (int it = tid; it < 1024; it += 256) {
          const int col = it >> 3, g8 = it & 7; float v[8];
#pragma unroll
          for (int e = 0; e < 8; ++e) v[e] = sC[(g8 * 8 + e) * cs + col];
          u32x4 wv = {pk_bf16(v[0], v[1]), pk_bf16(v[2], v[3]), pk_bf16(v[4], v[5]), pk_bf16(v[6], v[7])};
          *(u32x4*)(xt + ((size_t)bidx * xcols + xcb + col) * TPB + tin0 + half * 64 + g8 * 8) = wv;
        }
      } else {
        for (int it = tid; it < 512; it += 256) { const int row = it >> 3, c4 = (it & 7) * 4; const size_t token = (size_t)m0 + half * 64 + row;
          const f32x4 o = *(const f32x4*)(sC + row * cs + c4);
          *(f32x4*)(p.GZ + token * 32 + c4) = o; }
      }
      __syncthreads();
    }
  }
}

constexpr int TS = 72;
__device__ __forceinline__ f32x16 nt64(const bf16* sA, const bf16* sB, f32x16 acc) {
  const int tid = otid(); const int lane = tid & 63, w = tid >> 6, wi = w >> 1, wj = w & 1, l31 = lane & 31, lh = lane >> 5;
#pragma unroll
  for (int ks = 0; ks < 4; ++ks) {
    bf16x8 a = *(const bf16x8*)(sA + (wi * 32 + l31) * TS + ks * 16 + lh * 8);
    bf16x8 b = *(const bf16x8*)(sB + (wj * 32 + l31) * TS + ks * 16 + lh * 8);
    acc = MFMA32(a, b, acc);
  }
  return acc;
}

__device__ void gla_cumgate(const Params& p, int layer, int h, int dir, const float* sz, float* sb, float* stot) {
  const int tid = otid(), qtr = tid >> 6, k = tid & 63;
  const float* W = p.w_gg + ((size_t)(layer * 2 + dir) * 16) * 256 + h * 64 + k;
  float wv[16];
#pragma unroll
  for (int r = 0; r < 16; ++r) wv[r] = W[r * 256];
  const float bias = p.b_gg[(layer * 2 + dir) * 256 + h * 64 + k];
  float cum = 0.f;
#pragma unroll 4
  for (int i = 0; i < 16; ++i) {
    const int t = dir == 0 ? qtr * 16 + i : qtr * 16 + 15 - i;
    float z = bias;
    { const f32x4* zr = (const f32x4*)(sz + t * 32 + dir * 16);
#pragma unroll
      for (int r4 = 0; r4 < 4; ++r4) { const f32x4 zv = zr[r4]; z += zv[0] * wv[4 * r4] + zv[1] * wv[4 * r4 + 1] + zv[2] * wv[4 * r4 + 2] + zv[3] * wv[4 * r4 + 3]; } }
    const float ls = fminf(z, 0.f) - __builtin_amdgcn_logf(1.f + __builtin_amdgcn_exp2f(-fabsf(z) * 1.4426950408889634f)) * 0.6931471805599453f;
    cum += ls * 0.0625f;
    sb[t * 65 + k] = cum;
  }
  stot[qtr * 64 + k] = cum;
  __syncthreads();
  float off = 0.f;
#pragma unroll
  for (int q = 0; q < 4; ++q) if (dir == 0 ? q < qtr : q > qtr) off += stot[q * 64 + k];
#pragma unroll 4
  for (int i = 0; i < 16; ++i) sb[(qtr * 16 + i) * 65 + k] += off;
  __syncthreads();
}

constexpr int L_SB = 0, L_T0 = 16640, L_TSZ = 64 * TS * 2  ;

__device__ void gla_load_common(const Params& p, int b, int h, int chunk, float* sz, bf16* sVt) {
  const int tid = otid(); const size_t token0 = (size_t)b * TPB + chunk * 64;
#pragma unroll
  for (int i = 0; i < 8; ++i) { int it = tid + 256 * i; sz[it] = p.GZ[token0 * 32 + it]; }
#pragma unroll
  for (int i = 0; i < 2; ++i) { int it = tid + 256 * i; int dv = it >> 3, ch = it & 7;
    *(u32x4*)(sVt + dv * TS + ch * 8) = *(const u32x4*)(p.GVt + ((size_t)b * 256 + h * 64 + dv) * TPB + chunk * 64 + ch * 8); }
}

__device__ void gla_g1_item(const Params& p, int layer, int item, char* smem) {
  const int chunk = item % NCHUNK, bh = item / NCHUNK, b = bh >> 2, h = bh & 3;
  const int tid = otid(), lane = tid & 63, w = tid >> 6, wi = w >> 1, wj = w & 1, l31 = lane & 31, lh = lane >> 5;
  float* sb = (float*)(smem + L_SB);
  bf16* sKh = (bf16*)(smem + L_T0); bf16* sVt = (bf16*)(smem + L_T0 + L_TSZ); float* sz = (float*)(smem + L_T0 + 2 * L_TSZ); float* stot = (float*)(smem + L_T0 + 2 * L_TSZ + 8192);
  const size_t token0 = (size_t)b * TPB + chunk * 64;
  __syncthreads();
  gla_load_common(p, b, h, chunk, sz, sVt);
  __syncthreads();
  for (int dir = 0; dir < 2; ++dir) {
    gla_cumgate(p, layer, h, dir, sz, sb, stot);
    const int bend = dir == 0 ? 63 : 0; const int bhd = bh * 2 + dir;
    { const int s = tid & 63, dkg = tid >> 6;
      const u32x4* kp = (const u32x4*)(p.P + (token0 + s) * PW + PC_GK + h * 64 + dkg * 16);
      u32x4 k0 = kp[0], k1 = kp[1]; float kv[16];
#pragma unroll
      for (int e = 0; e < 4; ++e) { kv[2 * e] = bflo(k0[e]); kv[2 * e + 1] = bfhi(k0[e]); kv[8 + 2 * e] = bflo(k1[e]); kv[8 + 2 * e + 1] = bfhi(k1[e]); }
#pragma unroll
      for (int e = 0; e < 16; ++e) { const int dk = dkg * 16 + e; sKh[dk * TS + s] = f2bf(kv[e] * __expf(sb[bend * 65 + dk] - sb[s * 65 + dk])); } }
    if (tid < 64) p.DEC[((size_t)bhd * NCHUNK + chunk) * 64 + tid] = __expf(sb[bend * 65 + tid]);
    __syncthreads();
    f32x16 acc;
#pragma unroll
    for (int r = 0; r < 16; ++r) acc[r] = 0.f;
    acc = nt64(sVt, sKh, acc);
    float* dst = p.SlocT + ((size_t)bhd * NCHUNK + chunk) * 4096;
#pragma unroll
    for (int r = 0; r < 16; ++r) dst[(wi * 32 + crow(r, lh)) * 64 + wj * 32 + l31] = acc[r];
    __syncthreads();
  }
}

__device__ void gla_g2_item(const Params& p, int item) {
  const int bhd = item >> 2, part = item & 3, dir = bhd & 1; const int tid = otid();
  const int e = part * 1024 + tid * 4, dk = e & 63;
  const float* sl = p.SlocT + (size_t)bhd * NCHUNK * 4096 + e; const float* dc = p.DEC + (size_t)bhd * NCHUNK * 64 + dk; bf16* sp = p.Sprev + (size_t)bhd * NCHUNK * 4096 + e;
  float z0 = 0.f; asm volatile("" : "+v"(z0));
  f32x4 S = {z0, z0, z0, z0};
  int c = dir == 0 ? 0 : 3;
  f32x4 nsl = *(const f32x4*)(sl + (size_t)c * 4096), ndc = *(const f32x4*)(dc + c * 64);
  for (int s = 0; s < NCHUNK; ++s) {
    const f32x4 csl = nsl, cdc = ndc; const int cc = c;
    if (s + 1 < NCHUNK) { const int s1 = s + 1; c = dir == 0 ? s1 : (s1 < 4 ? 3 - s1 : 71 - s1); nsl = *(const f32x4*)(sl + (size_t)c * 4096); ndc = *(const f32x4*)(dc + c * 64); }
    u32x2 wv = {pk_bf16(S[0], S[1]), pk_bf16(S[2], S[3])};
    *(u32x2*)(sp + (size_t)cc * 4096) = wv;
    S = cdc * S + csl;
  }
}

__device__ void gla_g3_item(const Params& p, int layer, int item, char* smem) {
  const int chunk = item % NCHUNK, bh = item / NCHUNK, b = bh >> 2, h = bh & 3;
  const int tid = otid(), lane = tid & 63, w = tid >> 6, wi = w >> 1, wj = w & 1, l31 = lane & 31, lh = lane >> 5;
  float* sb = (float*)(smem + L_SB);
  bf16* sQ = (bf16*)(smem + L_T0); bf16* sK = (bf16*)(smem + L_T0 + L_TSZ); bf16* sVt = (bf16*)(smem + L_T0 + 2 * L_TSZ); bf16* sS = (bf16*)(smem + L_T0 + 3 * L_TSZ);
  bf16* sAT = sK; float* sz = (float*)sS; float* stot = (float*)sQ; float* so = sb;
  const size_t token0 = (size_t)b * TPB + chunk * 64;
  __syncthreads();
  gla_load_common(p, b, h, chunk, sz, sVt);
  __syncthreads();
  f32x16 att, acc;
#pragma unroll
  for (int r = 0; r < 16; ++r) { att[r] = 0.f; acc[r] = 0.f; }
  for (int dir = 0; dir < 2; ++dir) {
    if (dir == 1) {
#pragma unroll
      for (int i = 0; i < 8; ++i) { int it = tid + 256 * i; sz[it] = p.GZ[token0 * 32 + it]; }
      __syncthreads(); }
    gla_cumgate(p, layer, h, dir, sz, sb, stot);
    const int bhd = bh * 2 + dir;
    { const int t = tid >> 2, kg = (tid & 3) * 16;
      const u32x4* qp = (const u32x4*)(p.P + (token0 + t) * PW + PC_GQ + h * 64 + kg);
      const u32x4* kp = (const u32x4*)(p.P + (token0 + t) * PW + PC_GK + h * 64 + kg);
      u32x4 q0 = qp[0], q1 = qp[1], k0 = kp[0], k1 = kp[1]; unsigned qo[8], ko[8];
#pragma unroll
      for (int e = 0; e < 8; ++e) { const unsigned qw = e < 4 ? q0[e] : q1[e - 4], kw = e < 4 ? k0[e] : k1[e - 4];
        const float b0 = sb[t * 65 + kg + 2 * e], b1 = sb[t * 65 + kg + 2 * e + 1];
        qo[e] = pk_bf16(bflo(qw) * __expf(b0), bfhi(qw) * __expf(b1)); ko[e] = pk_bf16(bflo(kw) * __expf(-b0), bfhi(kw) * __expf(-b1)); }
      u32x4 w0 = {qo[0], qo[1], qo[2], qo[3]}, w1 = {qo[4], qo[5], qo[6], qo[7]}, w2 = {ko[0], ko[1], ko[2], ko[3]}, w3 = {ko[4], ko[5], ko[6], ko[7]};
      *(u32x4*)(sQ + t * TS + kg) = w0; *(u32x4*)(sQ + t * TS + kg + 8) = w1; *(u32x4*)(sK + t * TS + kg) = w2; *(u32x4*)(sK + t * TS + kg + 8) = w3; }
#pragma unroll
    for (int i = 0; i < 2; ++i) { int it = tid + 256 * i; int dv = it >> 3, ch = it & 7;
      *(u32x4*)(sS + dv * TS + ch * 8) = *(const u32x4*)(p.Sprev + ((size_t)bhd * NCHUNK + chunk) * 4096 + dv * 64 + ch * 8); }
    __syncthreads();
    f32x16 a;
#pragma unroll
    for (int r = 0; r < 16; ++r) a[r] = 0.f;
    a = nt64(sQ, sK, a);
#pragma unroll
    for (int r = 0; r < 16; ++r) { const int t = wi * 32 + crow(r, lh), s = wj * 32 + l31; const bool keep = dir == 0 ? (s <= t) : (s >= t); att[r] += keep ? a[r] : 0.f; }
    acc = nt64(sQ, sS, acc);
    __syncthreads();
  }
#pragma unroll
  for (int r = 0; r < 16; ++r) sAT[(wi * 32 + crow(r, lh)) * TS + wj * 32 + l31] = f2bf(att[r]);
  __syncthreads();
  acc = nt64(sAT, sVt, acc);
#pragma unroll
  for (int r = 0; r < 16; ++r) so[(wi * 32 + crow(r, lh)) * 65 + wj * 32 + l31] = acc[r];
  __syncthreads();
  { const int t = tid >> 2, part = tid & 3; float o[16]; float ss = 0.f;
#pragma unroll
    for (int e = 0; e < 16; ++e) { o[e] = so[t * 65 + part * 16 + e]; ss += o[e] * o[e]; }
    ss += __shfl_xor(ss, 1); ss += __shfl_xor(ss, 2);
    const float rn = rsqrtf(ss * (1.f / 64.f) + 1e-6f);
    const u32x4* gp = (const u32x4*)(p.P + (token0 + t) * PW + PC_GO + h * 64 + part * 16);
    u32x4 g0 = gp[0], g1 = gp[1]; unsigned ow[8]; const float* gn = p.gla_g + layer * 64 + part * 16;
#pragma unroll
    for (int e = 0; e < 8; ++e) { const unsigned gw = e < 4 ? g0[e] : g1[e - 4]; const float ga = bflo(gw), gb = bfhi(gw);
      const float y0 = o[2 * e] * rn * gn[2 * e] * (ga * __builtin_amdgcn_rcpf(1.f + __expf(-ga))), y1 = o[2 * e + 1] * rn * gn[2 * e + 1] * (gb * __builtin_amdgcn_rcpf(1.f + __expf(-gb)));
      ow[e] = pk_bf16(y0, y1); }
    u32x4 w0 = {ow[0], ow[1], ow[2], ow[3]}, w1 = {ow[4], ow[5], ow[6], ow[7]};
    bf16* dst = p.MIX + (token0 + t) * DM + h * 64 + part * 16;
    *(u32x4*)dst = w0; *(u32x4*)(dst + 8) = w1; }
  __syncthreads();
}

template <int DH>
__device__ void flash128(const bf16* Q, const bf16* K, const bf16* Vt, int s0a, int s0b, int s1a, int s1b, bool win, int qtok0, float m0, float l0, f32x16 (&O)[2], char* smem) {
  constexpr int KS = DH + 8; constexpr int NKC = DH / 32;
  const int tid = otid(), lane = tid & 63, w = tid >> 6, l31 = lane & 31, lh = lane >> 5;
  bf16* sK = (bf16*)smem; bf16* sV = sK + 64 * TS;
  bf16x8 qf[DH / 16];
  { const bf16* qp = Q + (size_t)(w * 32 + l31) * PW + lh * 8;
#pragma unroll
    for (int ks = 0; ks < DH / 16; ++ks) qf[ks] = *(const bf16x8*)(qp + ks * 16); }
  float m = m0, l = lh == 0 ? l0 : 0.f;
#pragma unroll
  for (int r = 0; r < 16; ++r) { O[0][r] = 0.f; O[1][r] = 0.f; }
  const int nt0 = (s0b - s0a) >> 6, nt1 = (s1b - s1a) >> 6, ntile = nt0 + nt1;
  u32x4 rk[NKC], rv[2];
  auto tstart = [&](int t) { return t < nt0 ? s0a + t * 64 : s1a + (t - nt0) * 64; };
  auto gload = [&](int t) { const int key0 = tstart(t);
#pragma unroll
    for (int i = 0; i < NKC; ++i) { int it = tid + 256 * i; int row = it / (DH / 8), ch = it % (DH / 8); rk[i] = *(const u32x4*)(K + (size_t)(key0 + row) * PW + ch * 8); }
#pragma unroll
    for (int i = 0; i < 2; ++i) { int it = tid + 256 * i; int dv = it >> 3, ch = it & 7; rv[i] = *(const u32x4*)(Vt + (size_t)dv * TPB + key0 + ch * 8); } };
  gload(0);
  for (int t = 0; t < ntile; ++t) {
    __syncthreads();
#pragma unroll
    for (int i = 0; i < NKC; ++i) { int it = tid + 256 * i; int row = it / (DH / 8), ch = it % (DH / 8); *(u32x4*)(sK + row * KS + ch * 8) = rk[i]; }
#pragma unroll
    for (int i = 0; i < 2; ++i) { int it = tid + 256 * i; int dv = it >> 3, ch = it & 7; *(u32x4*)(sV + dv * TS + ch * 8) = rv[i]; }
    __syncthreads();
    const int key0 = tstart(t); const bool domask = win && t >= nt0;
    if (t + 1 < ntile) gload(t + 1);
    f32x16 X[2];
#pragma unroll
    for (int kt2 = 0; kt2 < 2; ++kt2) {
#pragma unroll
      for (int r = 0; r < 16; ++r) X[kt2][r] = 0.f;
#pragma unroll
      for (int ks = 0; ks < DH / 16; ++ks) { bf16x8 a = *(const bf16x8*)(sK + (kt2 * 32 + l31) * KS + ks * 16 + lh * 8); X[kt2] = MFMA32(a, qf[ks], X[kt2]); }
    }
    if (domask) { const int qtok = qtok0 + w * 32 + l31;
#pragma unroll
      for (int kt2 = 0; kt2 < 2; ++kt2)
#pragma unroll
        for (int r = 0; r < 16; ++r) { const int d = key0 + kt2 * 32 + crow(r, lh) - qtok; if (d > 128 || d < -128) X[kt2][r] = -1e30f; } }
    float tmax = X[0][0];
#pragma unroll
    for (int r = 1; r < 16; ++r) tmax = fmaxf(tmax, X[0][r]);
#pragma unroll
    for (int r = 0; r < 16; ++r) tmax = fmaxf(tmax, X[1][r]);
    tmax = fmaxf(tmax, __shfl_xor(tmax, 32));
    if (!__all(tmax <= m + 8.f)) {
      const float mn = fmaxf(m, tmax); const float alpha = __builtin_amdgcn_exp2f(m - mn); m = mn; l *= alpha;
#pragma unroll
      for (int r = 0; r < 16; ++r) { O[0][r] *= alpha; O[1][r] *= alpha; }
    }
    X[0] = X[0] - m; X[1] = X[1] - m;
#pragma unroll
    for (int kt2 = 0; kt2 < 2; ++kt2)
#pragma unroll
      for (int r = 0; r < 16; ++r) X[kt2][r] = __builtin_amdgcn_exp2f(X[kt2][r]);
    { const f32x16 sv = X[0] + X[1]; float ps = 0.f;
#pragma unroll
      for (int r = 0; r < 16; ++r) ps += sv[r];
      l += ps; }
#pragma unroll
    for (int kt2 = 0; kt2 < 2; ++kt2)
#pragma unroll
      for (int s = 0; s < 2; ++s) {
        u32x4 pw = {pk_bf16(X[kt2][8 * s], X[kt2][8 * s + 1]), pk_bf16(X[kt2][8 * s + 2], X[kt2][8 * s + 3]), pk_bf16(X[kt2][8 * s + 4], X[kt2][8 * s + 5]), pk_bf16(X[kt2][8 * s + 6], X[kt2][8 * s + 7])};
        bf16x8 pb = *reinterpret_cast<bf16x8*>(&pw);
#pragma unroll
        for (int dt = 0; dt < 2; ++dt) {
          const bf16* vp = sV + (dt * 32 + l31) * TS + kt2 * 32 + s * 16 + lh * 4;
          u32x2 lo = *(const u32x2*)vp, hi = *(const u32x2*)(vp + 8);
          u32x4 vw = {lo[0], lo[1], hi[0], hi[1]};
          bf16x8 va = *reinterpret_cast<bf16x8*>(&vw);
          O[dt] = MFMA32(va, pb, O[dt]);
        }
      }
  }
  l += __shfl_xor(l, 32);
  const float inv = 1.f / l;
#pragma unroll
  for (int r = 0; r < 16; ++r) { O[0][r] *= inv; O[1][r] *= inv; }
}

__device__ __forceinline__ void store_ot(bf16* base  , const f32x16 (&O)[2]) {
  const int tid = otid(); const int lane = tid & 63, w = tid >> 6, l31 = lane & 31, lh = lane >> 5;
  bf16* rowp = base + (size_t)(w * 32 + l31) * DM;
#pragma unroll
  for (int dt = 0; dt < 2; ++dt)
#pragma unroll
    for (int g = 0; g < 4; ++g) { u32x2 wv = {pk_bf16(O[dt][4 * g], O[dt][4 * g + 1]), pk_bf16(O[dt][4 * g + 2], O[dt][4 * g + 3])};
      *(u32x2*)(rowp + dt * 32 + 8 * g + 4 * lh) = wv; }
}

__device__ void diff_item(const Params& p, int layer, int item, char* smem) {
  const int qb = 33 - item / 32, bh = item % 32, b = bh >> 2, h = bh & 3;
  const int tid = otid(), lane = tid & 63, w = tid >> 6, l31 = lane & 31, lh = lane >> 5;
  const bool isctx = qb < 2; const int ntile = (isctx ? CTXL : TPB) >> 6;
  if (isctx && layer == DEPTH - 1) return;
  const size_t qrow0 = (size_t)b * TPB + qb * 128;
  const bf16* K = p.P + (size_t)b * TPB * PW + PC_DK + h * 64; const bf16* Vt = p.DVt + ((size_t)b * 256 + h * 64) * TPB;
  bf16* sK = (bf16*)smem; bf16* sV = sK + 64 * TS;
  bf16x8 qf[2][2];
  { const bf16* qp = p.P + (qrow0 + w * 32 + l31) * PW + PC_DQ + h * 64 + lh * 8;
#pragma unroll
    for (int c = 0; c < 2; ++c)
#pragma unroll
      for (int ks = 0; ks < 2; ++ks) qf[c][ks] = *(const bf16x8*)(qp + c * 32 + ks * 16); }
  float m[2] = {-1e30f, -1e30f}, l[2] = {0.f, 0.f};
  f32x16 O[2][2];
#pragma unroll
  for (int c = 0; c < 2; ++c)
#pragma unroll
    for (int dt = 0; dt < 2; ++dt)
#pragma unroll
      for (int r = 0; r < 16; ++r) O[c][dt][r] = 0.f;
  u32x4 rk[2], rv[2];
  auto gload = [&](int t) { const int key0 = t * 64;
#pragma unroll
    for (int i = 0; i < 2; ++i) { int it = tid + 256 * i; int row = it >> 3, ch = it & 7; rk[i] = *(const u32x4*)(K + (size_t)(key0 + row) * PW + ch * 8); rv[i] = *(const u32x4*)(Vt + (size_t)row * TPB + key0 + ch * 8); } };
  gload(0);
  for (int t = 0; t < ntile; ++t) {
    __syncthreads();
#pragma unroll
    for (int i = 0; i < 2; ++i) { int it = tid + 256 * i; int row = it >> 3, ch = it & 7; *(u32x4*)(sK + row * TS + ch * 8) = rk[i]; *(u32x4*)(sV + row * TS + ch * 8) = rv[i]; }
    __syncthreads();
    if (t + 1 < ntile) gload(t + 1);
    u32x4 pw[2][2][2];
#pragma unroll
    for (int c = 0; c < 2; ++c) {
      f32x16 X[2];
#pragma unroll
      for (int kt2 = 0; kt2 < 2; ++kt2) {
#pragma unroll
        for (int r = 0; r < 16; ++r) X[kt2][r] = 0.f;
#pragma unroll
        for (int ks = 0; ks < 2; ++ks) { bf16x8 a = *(const bf16x8*)(sK + (kt2 * 32 + l31) * TS + c * 32 + ks * 16 + lh * 8); X[kt2] = MFMA32(a, qf[c][ks], X[kt2]); }
      }
      float tmax = X[0][0];
#pragma unroll
      for (int r = 1; r < 16; ++r) tmax = fmaxf(tmax, X[0][r]);
#pragma unroll
      for (int r = 0; r < 16; ++r) tmax = fmaxf(tmax, X[1][r]);
      tmax = fmaxf(tmax, __shfl_xor(tmax, 32));
      if (!__all(tmax <= m[c] + 8.f)) {
        const float mn = fmaxf(m[c], tmax); const float alpha = __builtin_amdgcn_exp2f(m[c] - mn); m[c] = mn; l[c] *= alpha;
#pragma unroll
        for (int r = 0; r < 16; ++r) { O[c][0][r] *= alpha; O[c][1][r] *= alpha; }
      }
      X[0] = X[0] - m[c]; X[1] = X[1] - m[c];
#pragma unroll
      for (int kt2 = 0; kt2 < 2; ++kt2)
#pragma unroll
        for (int r = 0; r < 16; ++r) X[kt2][r] = __builtin_amdgcn_exp2f(X[kt2][r]);
      { const f32x16 sv = X[0] + X[1]; float ps = 0.f;
#pragma unroll
        for (int r = 0; r < 16; ++r) ps += sv[r];
        l[c] += ps; }
#pragma unroll
      for (int kt2 = 0; kt2 < 2; ++kt2)
#pragma unroll
        for (int s2 = 0; s2 < 2; ++s2) {
          u32x4 t4 = {pk_bf16(X[kt2][8 * s2], X[kt2][8 * s2 + 1]), pk_bf16(X[kt2][8 * s2 + 2], X[kt2][8 * s2 + 3]), pk_bf16(X[kt2][8 * s2 + 4], X[kt2][8 * s2 + 5]), pk_bf16(X[kt2][8 * s2 + 6], X[kt2][8 * s2 + 7])};
          pw[c][kt2][s2] = t4; }
    }
#pragma unroll
    for (int kt2 = 0; kt2 < 2; ++kt2)
#pragma unroll
      for (int s2 = 0; s2 < 2; ++s2)
#pragma unroll
        for (int dt = 0; dt < 2; ++dt) {
          const bf16* vp = sV + (dt * 32 + l31) * TS + kt2 * 32 + s2 * 16 + lh * 4;
          u32x2 lo = *(const u32x2*)vp, hi = *(const u32x2*)(vp + 8);
          u32x4 vw = {lo[0], lo[1], hi[0], hi[1]};
          const bf16x8 va = __builtin_bit_cast(bf16x8, vw);
          O[0][dt] = MFMA32(va, __builtin_bit_cast(bf16x8, pw[0][kt2][s2]), O[0][dt]);
          O[1][dt] = MFMA32(va, __builtin_bit_cast(bf16x8, pw[1][kt2][s2]), O[1][dt]);
        }
  }
  const float l0 = l[0] + __shfl_xor(l[0], 32), l1 = l[1] + __shfl_xor(l[1], 32);
  const float lam = p.LAM[layer * 2], li = p.LAM[layer * 2 + 1];
  const float i0 = 1.f / l0, i1 = lam / l1;
  float ss = 0.f;
#pragma unroll
  for (int dt = 0; dt < 2; ++dt)
#pragma unroll
    for (int r = 0; r < 16; ++r) { const float o = O[0][dt][r] * i0 - O[1][dt][r] * i1; O[0][dt][r] = o; ss += o * o; }
  ss += __shfl_xor(ss, 32);
  const float rn = rsqrtf(ss * (1.f / 64.f) + 1e-6f) * (1.f - li);
  const float* g = p.diff_g + layer * 64;
#pragma unroll
  for (int dt = 0; dt < 2; ++dt)
#pragma unroll
    for (int r = 0; r < 16; ++r) O[0][dt][r] *= rn * g[dt * 32 + crow(r, lh)];
  store_ot(p.MIX + qrow0 * DM + 256 + h * 64, O[0]);
}

__device__ void swa_item(const Params& p, int layer, int item, char* smem) {
  const int qb = item / 64, bhh = item % 64, b = bhh >> 3, hh = bhh & 7, g = hh >> 2;
  const bool isctx = qb < 2; const size_t qrow0 = (size_t)b * TPB + qb * 128;
  if (isctx && layer == DEPTH - 1) return;
  const bf16* Kb = p.P + (size_t)b * TPB * PW + PC_SK + g * 64; const bf16* Vt = p.SVt + ((size_t)b * 128 + g * 64) * TPB;
  int s1a = 0, s1b = 0;
  if (!isctx) { const int i = qb - 2; int lo = 128 * (i - 1), hi = 128 * (i + 2); lo = lo < 0 ? 0 : lo; hi = hi > SEQL ? SEQL : hi; s1a = CTXL + lo; s1b = CTXL + hi; }
  f32x16 O[2];
  flash128<64>(p.P + qrow0 * PW + PC_SQ + hh * 64, Kb, Vt, 0, CTXL, s1a, s1b, true, qb * 128, p.sink[layer * 8 + hh] * 1.4426950408889634f, 1.f, O, smem);
  store_ot(p.MIX + qrow0 * DM + 512 + hh * 64, O);
}

enum { PH_PREP = 0, PH_ROW, PH_INPROJ, PH_M1, PH_M2, PH_G3, PH_OUTPROJ, PH_FFNUP, PH_FFNDOWN };
constexpr int N_G1 = NBATCH * 4 * NCHUNK  , N_SWA = 34 * 64  , N_G2 = 256, N_DIFF = 34 * 32  ;

template <int PH> __device__ __forceinline__ int phase_items() {
  return PH == PH_PREP ? PREP_ITEMS : PH == PH_ROW ? TTOK / 16 : PH == PH_INPROJ ? 272 * 21 : PH == PH_M1 ? N_G1 + N_SWA : PH == PH_M2 ? N_G2 + N_DIFF :
         PH == PH_G3 ? N_G1 : PH == PH_OUTPROJ ? 272 * 8 : PH == PH_FFNUP ? 272 * 44 : 272 * 8;
}
template <int PH> __device__ __forceinline__ void run_item(const Params& p, int layer, int sub, int item, char* smem) {
  if (PH == PH_PREP) prep_item(p, item, smem);
  else if (PH == PH_ROW) rowpass_item(p, layer, sub, item);
  else if (PH == PH_M1) { if (item < N_G1) gla_g1_item(p, layer, item, smem); else { __syncthreads(); swa_item(p, layer, item - N_G1, smem); } }
  else if (PH == PH_M2) { if (item < N_G2) gla_g2_item(p, item); else { __syncthreads(); diff_item(p, layer, item - N_G2, smem); } }
  else if (PH == PH_G3) gla_g3_item(p, layer, item, smem);
}
template <int PH> __device__ __forceinline__ void run_phase(const Params& p, int layer, int sub, char* smem) {
  if (PH == PH_INPROJ || PH == PH_OUTPROJ || PH == PH_FFNUP || PH == PH_FFNDOWN) {
    constexpr int NTN = PH == PH_INPROJ ? 21 : (PH == PH_FFNUP ? 44 : 8);
    const int nl = gridDim.x >> 3, xcd = blockIdx.x & 7;
    constexpr int BANDT = (PH == PH_INPROJ || PH == PH_FFNUP) ? 17 : 34;
    for (int q = blockIdx.x >> 3; q < BANDT * NTN; q += nl) {
      if (PH == PH_INPROJ) gemm_item<G_INPROJ>(p, layer, xcd, q, smem);
      else if (PH == PH_OUTPROJ) gemm_item<G_OUTPROJ>(p, layer, xcd, q, smem);
      else if (PH == PH_FFNUP) gemm_item<G_FFNUP>(p, layer, xcd, q, smem);
      else gemm_item<G_FFNDOWN>(p, layer, xcd, q, smem);
    }
    return;
  }
  const int n = phase_items<PH>();
  for (int item = blockIdx.x; item < n; item += gridDim.x) run_item<PH>(p, layer, sub, item, smem);
}

#ifndef B2MASK
#define B2MASK 0x1FF
#endif
template <int PH> __global__ void __launch_bounds__(256, ((B2MASK >> PH) & 1) ? 2 : 1) k_phase(Params p, int layer, int sub) {
  __shared__ __attribute__((aligned(16))) char smem[SMEM_BYTES];
  run_phase<PH>(p, layer, sub, smem);
}

__device__ __forceinline__ void grid_barrier(unsigned* bar, unsigned target) {
  asm volatile("s_waitcnt vmcnt(0)" ::: "memory");
  __syncthreads();
  if (threadIdx.x == 0) {
    __builtin_amdgcn_fence(__ATOMIC_RELEASE, "agent");
    asm volatile("s_waitcnt vmcnt(0)" ::: "memory");
    __hip_atomic_fetch_add(bar, 1u, __ATOMIC_RELAXED, __HIP_MEMORY_SCOPE_AGENT);
    const unsigned long long t0 = __builtin_amdgcn_s_memrealtime();
    while (__hip_atomic_load(bar, __ATOMIC_RELAXED, __HIP_MEMORY_SCOPE_AGENT) < target) {
      __builtin_amdgcn_s_sleep(1);
      if (__builtin_amdgcn_s_memrealtime() - t0 > 200000000ull) { __hip_atomic_store(bar + 32, 1u, __ATOMIC_RELAXED, __HIP_MEMORY_SCOPE_AGENT); break; }
    }
    __builtin_amdgcn_fence(__ATOMIC_ACQUIRE, "agent");
    asm volatile("s_waitcnt vmcnt(0)" ::: "memory");
  }
  __syncthreads();
}
#define GSYNC() do { nbar += 2; grid_barrier(p.BAR, (nbar - 1) * gridDim.x, nbar * gridDim.x); } while (0)
#define XB_TMO      128
#define XB_XCNT(j)  (256  + 64 * (j))
#define XB_XSUB(j)  (1280 + 64 * (j))
#define XB_XGEN(j)  (2304 + 64 * (j))
#define XB_TOP      3328
#define XB_TOPGEN   3392
#define XCD_BAR_WORDS 3456
#define XB_SPIN_CAP (1u << 18)
#define LAS __attribute__((address_space(3)))

__device__ __forceinline__ unsigned xb_ld(unsigned* p)              { return __hip_atomic_load(p, __ATOMIC_RELAXED, __HIP_MEMORY_SCOPE_AGENT); }
__device__ __forceinline__ unsigned xb_add(unsigned* p, unsigned v) { return __hip_atomic_fetch_add(p, v, __ATOMIC_RELAXED, __HIP_MEMORY_SCOPE_AGENT); }
__device__ __forceinline__ unsigned xb_xcc_id() { return (unsigned)__builtin_amdgcn_s_getreg((3 << 11) | 20) & 0xFu; }
#define XB_SPIN(cond, bar) do { unsigned _sp = 0; while (cond) { __builtin_amdgcn_s_sleep(1); \
    if ((++_sp & 255u) == 0u) { if (xb_ld(&(bar)[XB_TMO])) break; if (_sp > XB_SPIN_CAP) { atomicAdd(&(bar)[XB_TMO], 1u); break; } } } } while (0)

struct XcdBarrier {
    unsigned* bar; unsigned x;
    volatile LAS unsigned* st;
};

__device__ __forceinline__ XcdBarrier xcd_barrier_post(unsigned* bar, volatile LAS unsigned* st) {
    XcdBarrier b; b.bar = bar; b.x = xb_xcc_id(); b.st = st;
    if (threadIdx.x == 0) (void)xb_add(&bar[XB_XCNT(b.x)], 1u);
    return b;
}
__device__ __forceinline__ void xcd_barrier_complete(unsigned* bar, unsigned x, unsigned& nloc, unsigned& nx) {
    const unsigned G = gridDim.x * gridDim.y * gridDim.z;
    unsigned sum, cnt, mine, sp = 0u;
    for (;;) {
        sum = 0u; cnt = 0u; mine = 0u;
#pragma unroll
        for (unsigned j = 0; j < 16; ++j) { const unsigned c = xb_ld(&bar[XB_XCNT(j)]); sum += c; cnt += (c > 0u) ? 1u : 0u; mine = (j == x) ? c : mine; }
        if (sum == G) break;
        __builtin_amdgcn_s_sleep(1);
        if ((++sp & 255u) == 0u) { if (xb_ld(&bar[XB_TMO])) break; if (sp > XB_SPIN_CAP) { atomicAdd(&bar[XB_TMO], 1u); break; } }
    }
    nloc = mine > 0u ? mine : 1u; nx = cnt > 0u ? cnt : 1u;
}

__device__ __forceinline__ void xcd_barrier(const XcdBarrier& b) {
    asm volatile("s_waitcnt vmcnt(0)" ::: "memory");
    __syncthreads();
    if (threadIdx.x == 0) {
        unsigned* bar = b.bar;
        __builtin_amdgcn_s_waitcnt(0);
        unsigned nloc = b.st[0], nx = b.st[1];
        if (nloc == 0u) { xcd_barrier_complete(bar, b.x, nloc, nx); b.st[0] = nloc; b.st[1] = nx; }
        const unsigned old = xb_add(&bar[XB_XSUB(b.x)], 1u);
        const unsigned gen = old / nloc;
        if (old + 1u == (gen + 1u) * nloc) {
            __builtin_amdgcn_fence(__ATOMIC_RELEASE, "agent");
            asm volatile("s_waitcnt vmcnt(0)" ::: "memory");
            const unsigned og = xb_add(&bar[XB_TOP], 1u);
            const unsigned tg = og / nx;
            if (og + 1u == (tg + 1u) * nx) xb_add(&bar[XB_TOPGEN], 1u);
            else XB_SPIN(xb_ld(&bar[XB_TOPGEN]) == tg, bar);
            __builtin_amdgcn_fence(__ATOMIC_ACQUIRE, "agent");
            xb_add(&bar[XB_XGEN(b.x)], 1u);
            asm volatile("s_waitcnt vmcnt(0)" ::: "memory");
        } else {
            XB_SPIN(xb_ld(&bar[XB_XGEN(b.x)]) == gen, bar);
            __builtin_amdgcn_fence(__ATOMIC_ACQUIRE, "agent");
            asm volatile("s_waitcnt vmcnt(0)" ::: "memory");
        }
    }
    __syncthreads();
}

__device__ __forceinline__ void run_program_phase(const Params& p, int ph, char* smem) {
  if (ph == 0) { run_phase<PH_PREP>(p, 0, 0, smem); return; }
  if (ph == 37) { run_phase<PH_ROW>(p, DEPTH, 0, smem); return; }
  const int layer = (ph - 1) / 9, k = (ph - 1) % 9;
  switch (k) {
    case 0: run_phase<PH_ROW>(p, layer, 0, smem); break;
    case 1: run_phase<PH_INPROJ>(p, layer, 0, smem); break;
    case 2: run_phase<PH_M1>(p, layer, 0, smem); break;
    case 3: run_phase<PH_M2>(p, layer, 0, smem); break;
    case 4: run_phase<PH_G3>(p, layer, 0, smem); break;
    case 5: run_phase<PH_OUTPROJ>(p, layer, 0, smem); break;
    case 6: run_phase<PH_ROW>(p, layer, 1, smem); break;
    case 7: run_phase<PH_FFNUP>(p, layer, 0, smem); break;
    default: run_phase<PH_FFNDOWN>(p, layer, 0, smem); break;
  }
}
__global__ void __launch_bounds__(256, 2) k_mega(Params p, int ph_lo, int ph_hi, int bar_slot) {
  __shared__ __attribute__((aligned(16))) char smem[SMEM_BYTES];
#if COOP
  if (ph_lo < 0) cg::this_grid().sync();
#endif
  unsigned nbar = 0;
  unsigned* bar = p.BAR + bar_slot * 64;
  (void)nbar; (void)bar;
  volatile LAS unsigned* xst = (volatile LAS unsigned*)(smem + SMEM_BYTES - 16);
  if (threadIdx.x == 0) { xst[0] = 0u; xst[1] = 0u; }
  __syncthreads();
  XcdBarrier xb = xcd_barrier_post(p.BAR, xst);
#pragma unroll 1
  for (int ph = ph_lo; ph < ph_hi; ++ph) {
    run_program_phase(p, ph, smem);
#ifdef REPEAT_MASK
    if (ph >= 1 && ph < 37 && ((REPEAT_MASK >> ((ph - 1) % 9)) & 1)) { ++nbar; grid_barrier(bar, nbar * gridDim.x); run_program_phase(p, ph, smem); }
#endif
    if (ph + 1 < ph_hi) xcd_barrier(xb);
#ifdef DOUBLE_BAR
    if (ph + 1 < ph_hi) xcd_barrier(xb);
#endif
  }
}

extern "C" void kernel_launch(void* const* d_in, const int* in_sizes, int n_in, void* d_out, int out_size, void* d_ws, size_t ws_size, hipStream_t stream) {
  Params p{};
  p.x = (const float*)d_in[0]; p.c = (const float*)d_in[1]; p.ctx = (const float*)d_in[2]; p.c_ctx = (const float*)d_in[3];
  p.w_ada = (const float*)d_in[4]; p.b_ada = (const float*)d_in[5]; p.w_in = (const float*)d_in[6]; p.w_gg = (const float*)d_in[7]; p.b_gg = (const float*)d_in[8];
  p.gla_g = (const float*)d_in[9]; p.dlam = (const float*)d_in[10]; p.diff_g = (const float*)d_in[11]; p.sink = (const float*)d_in[12]; p.w_out = (const float*)d_in[13];
  p.ln_g = (const float*)d_in[14]; p.ln_b = (const float*)d_in[15]; p.w_fg = (const float*)d_in[16]; p.w_fu = (const float*)d_in[17]; p.w_fd = (const float*)d_in[18];
  p.out = (float*)d_out;
  char* ws = (char*)d_ws; size_t off = 0;
  auto take = [&](size_t bytes) { char* r = ws + off; off += (bytes + 255) & ~(size_t)255; return r; };
  p.Z = (float*)take((size_t)TTOK * DM * 4);
  p.MIX = (bf16*)take((size_t)TTOK * DM * 2);
  p.P = (bf16*)take((size_t)TTOK * PW * 2);
  p.HID = p.MIX;
  p.GVt = (bf16*)take((size_t)NBATCH * 256 * TPB * 2);
  p.DVt = (bf16*)take((size_t)NBATCH * 256 * TPB * 2);
  p.SVt = (bf16*)take((size_t)NBATCH * 128 * TPB * 2);
  p.GZ = (float*)take((size_t)TTOK * 32 * 4);
  p.U = (bf16*)take((size_t)TTOK * DM * 2);
  p.SlocT = (float*)p.U;
  p.Sprev = (bf16*)take((size_t)64 * NCHUNK * 4096 * 2);
  p.MOD = (float*)take((size_t)DEPTH * 9 * 6144 * 4);
  p.ST = (float*)take((size_t)TTOK * 2 * 4);
  p.DEC = (float*)take((size_t)64 * NCHUNK * 64 * 4);
  p.TAB32 = (float*)take(64 * 8 * 2 * 4);
  p.TAB64 = (float*)take(64 * 16 * 2 * 4);
  p.LAM = (float*)take(256);
  p.BAR = (unsigned*)take(16384);
  if (off > ws_size) { fprintf(stderr, "workspace too small: need %zu have %zu\n", off, ws_size); return; }
  { char* o = (char*)d_out; size_t oo = 0;
    p.WinT = (bf16*)(o + oo); oo += (size_t)DEPTH * WIN_ROWS * DM * 2;
    p.WoT = (bf16*)(o + oo); oo += (size_t)DEPTH * DM * DM * 2;
    p.WguT = (bf16*)(o + oo); oo += (size_t)DEPTH * 5632 * DM * 2;
    p.WdT = (bf16*)(o + oo); oo += (size_t)DEPTH * DM * FFNH * 2; }
#if MEGA
  static int grid_blocks = 0;
  if (!grid_blocks) { int dev = 0, cus = 0, per_cu = 0; (void)hipGetDevice(&dev); (void)hipDeviceGetAttribute(&cus, hipDeviceAttributeMultiprocessorCount, dev);
    (void)hipOccupancyMaxActiveBlocksPerMultiprocessor(&per_cu, k_mega, 256, 0); if (per_cu > 2) per_cu = 2; if (per_cu < 1) per_cu = 1; grid_blocks = (cus * per_cu) & ~7; if (grid_blocks < 8) grid_blocks = 8; }
  (void)hipMemsetAsync(p.BAR, 0, 16384, stream);
  int cuts[48]; int ncut = 0; cuts[ncut++] = 0;
  if (!((FUSE >> 9) & 1)) cuts[ncut++] = 1;
  for (int ph = 1; ph < 37; ++ph) { const int k = (ph - 1) % 9; if (!((FUSE >> k) & 1)) cuts[ncut++] = ph + 1; }
  cuts[ncut++] = 38;
  for (int i = 0; i + 1 < ncut; ++i) if (cuts[i + 1] > cuts[i]) {
#if COOP
    int lo = cuts[i], hi = cuts[i + 1], slot = i; void* args[] = {&p, &lo, &hi, &slot};
    hipError_t e = hipLaunchCooperativeKernel((void*)k_mega, dim3(grid_blocks), dim3(256), args, 0, stream);
    if (e != hipSuccess) fprintf(stderr, "cooperative launch failed: %s (grid %d)\n", hipGetErrorString(e), grid_blocks);
#else
    k_mega<<<grid_blocks, 256, 0, stream>>>(p, cuts[i], cuts[i + 1], i);
#endif
  }
#else
  const int G = 2048;
  k_phase<PH_PREP><<<G, 256, 0, stream>>>(p, 0, 0);
  for (int layer = 0; layer < DEPTH; ++layer) {
    k_phase<PH_ROW><<<G, 256, 0, stream>>>(p, layer, 0);
    k_phase<PH_INPROJ><<<G, 256, 0, stream>>>(p, layer, 0);
    k_phase<PH_M1><<<G, 256, 0, stream>>>(p, layer, 0);
    k_phase<PH_M2><<<G, 256, 0, stream>>>(p, layer, 0);
    k_phase<PH_G3><<<G, 256, 0, stream>>>(p, layer, 0);
    k_phase<PH_OUTPROJ><<<G, 256, 0, stream>>>(p, layer, 0);
    k_phase<PH_ROW><<<G, 256, 0, stream>>>(p, layer, 1);
    k_phase<PH_FFNUP><<<G, 256, 0, stream>>>(p, layer, 0);
    k_phase<PH_FFNDOWN><<<G, 256, 0, stream>>>(p, layer, 0);
  }
  k_phase<PH_ROW><<<G, 256, 0, stream>>>(p, DEPTH, 0);
#endif
}
```

```cpp
#include <hip/hip_runtime.h>
#include <hip/hip_cooperative_groups.h>
#include <stdint.h>
#include <stdio.h>
namespace cg = cooperative_groups;

#ifndef COOP
#define COOP 1
#endif
#ifndef DELAY_ITERS
#define DELAY_ITERS 0
#endif
#ifndef FUSE
#define FUSE 0x3FF
#endif
#ifndef MEGA
#define MEGA 1
#endif

typedef unsigned short bf16;
typedef __attribute__((ext_vector_type(8))) short bf16x8;
typedef __attribute__((ext_vector_type(4))) short bf16x4;
typedef __attribute__((ext_vector_type(16))) float f32x16;
typedef __attribute__((ext_vector_type(4))) float f32x4;
typedef __attribute__((ext_vector_type(4))) unsigned u32x4;
typedef __attribute__((ext_vector_type(2))) unsigned u32x2;

constexpr int DM = 1024, NBATCH = 8, SEQL = 4096, CTXL = 256, TPB = 4352, TTOK = 34816, DEPTH = 4, FFNH = 2816;
constexpr int NCHUNK = 68;
constexpr int PW = 1920;
constexpr int PC_GQ = 0, PC_GK = 256, PC_GO = 512, PC_DQ = 768, PC_DK = 1024, PC_SQ = 1280, PC_SK = 1792;
constexpr int WIN_ROWS = 2688;
constexpr float DN_ALPHA = 1.6817928305074292f;
constexpr int SMEM_BYTES = 61440;

struct Params {
  const float *x, *c, *ctx, *c_ctx, *w_ada, *b_ada, *w_in, *w_gg, *b_gg, *gla_g, *dlam, *diff_g, *sink, *w_out, *ln_g, *ln_b, *w_fg, *w_fu, *w_fd;
  float* out;
  float* Z; bf16* U; bf16* MIX; bf16* P; bf16* GVt; bf16* DVt; bf16* SVt; float* GZ; bf16* HID;
  float* SlocT; bf16* Sprev; float* DEC; float* MOD; float* ST; float* TAB32; float* TAB64; float* LAM; unsigned* BAR;
  bf16 *WinT, *WoT, *WguT, *WdT;
};

typedef float f32x2v __attribute__((ext_vector_type(2)));
typedef __bf16 bf16x2v __attribute__((ext_vector_type(2)));
__device__ __forceinline__ unsigned pk_bf16(float lo, float hi) { f32x2v f = {lo, hi}; bf16x2v b = __builtin_convertvector(f, bf16x2v); return __builtin_bit_cast(unsigned, b); }
__device__ __forceinline__ bf16 f2bf(float x) { return (bf16)(pk_bf16(x, 0.f) & 0xffffu); }
__device__ __forceinline__ float bf2f(unsigned short x) { return __uint_as_float(((unsigned)x) << 16); }
__device__ __forceinline__ float bflo(unsigned w) { return __uint_as_float(w << 16); }
__device__ __forceinline__ float bfhi(unsigned w) { return __uint_as_float(w & 0xffff0000u); }
__device__ __forceinline__ int crow(int r, int hi) { return (r & 3) + 8 * (r >> 2) + 4 * hi; }
__device__ __forceinline__ float wave_sum(float v) {
#pragma unroll
  for (int o = 32; o >= 1; o >>= 1) v += __shfl_xor(v, o);
  return v;
}
__device__ __forceinline__ int otid() { int t = threadIdx.x; asm volatile("" : "+v"(t)); return t; }
#define MFMA32(a, b, c) __builtin_amdgcn_mfma_f32_32x32x16_bf16((a), (b), (c), 0, 0, 0)

constexpr int PREP_T_PER_LAYER = 3016, PREP_T = 4 * PREP_T_PER_LAYER, PREP_MOD = 384, PREP_ITEMS = PREP_T + PREP_MOD + 1;

__device__ void transpose_tile(const float* src, int N, bf16* dst, int ldd, int n0, int k0, int drow0, char* smem, int packK = 0) {
  float* tile = (float*)smem;
  const int tid = otid();
#pragma unroll
  for (int i = 0; i < 4; ++i) { const int k = (tid >> 3) + 32 * i, n4 = (tid & 7) * 4; const f32x4 v = *(const f32x4*)(src + (size_t)(k0 + k) * N + n0 + n4);
    tile[k * 33 + n4] = v[0]; tile[k * 33 + n4 + 1] = v[1]; tile[k * 33 + n4 + 2] = v[2]; tile[k * 33 + n4 + 3] = v[3]; }
  __syncthreads();
#pragma unroll
  for (int u = 0; u < 2; ++u) { const int it = tid + 256 * u; const int n = it >> 4, kg = it & 15; float v[8];
#pragma unroll
    for (int e = 0; e < 8; ++e) v[e] = tile[(kg * 8 + e) * 33 + n];
    u32x4 w = {pk_bf16(v[0], v[1]), pk_bf16(v[2], v[3]), pk_bf16(v[4], v[5]), pk_bf16(v[6], v[7])};
    const int nn = drow0 + n, kk = k0 + kg * 8;
    if (packK) *(u32x4*)(dst + ((((size_t)(nn >> 5) * (packK >> 4) + (kk >> 4)) * 2 + ((kk >> 3) & 1)) * 32 + (nn & 31)) * 8) = w;
    else *(u32x4*)(dst + (size_t)nn * ldd + kk) = w; }
  __syncthreads();
}

__device__ void prep_item(const Params& p, int item0, char* smem) {
  const int tid = otid();
  const int item = item0 < PREP_MOD ? PREP_T + item0 : (item0 < PREP_MOD + PREP_T ? item0 - PREP_MOD : item0);
  if (item < PREP_T) {
    int l = item / PREP_T_PER_LAYER, ti = item % PREP_T_PER_LAYER;
    if (ti < 648) { int nt = ti / 8, kt = ti % 8; int n0 = nt * 32; int dr = n0 < 1024 ? n0 : (n0 < 1056 ? 2560 + (n0 - 1024) : n0 - 32);
      transpose_tile(p.w_in + (size_t)l * 1024 * 2592, 2592, p.WinT + (size_t)l * WIN_ROWS * 1024, 1024, n0, kt * 128, dr, smem); }
    else if (ti < 904) { ti -= 648; int nt = ti / 8, kt = ti % 8;
      transpose_tile(p.w_out + (size_t)l * 1024 * 1024, 1024, p.WoT + (size_t)l * 1024 * 1024, 1024, nt * 32, kt * 128, nt * 32, smem, 1024); }
    else if (ti < 1608) { ti -= 904; int nt = ti / 8, kt = ti % 8;
      transpose_tile(p.w_fg + (size_t)l * 1024 * FFNH, FFNH, p.WguT + (size_t)l * 5632 * 1024, 1024, nt * 32, kt * 128, nt * 64, smem); }
    else if (ti < 2312) { ti -= 1608; int nt = ti / 8, kt = ti % 8;
      transpose_tile(p.w_fu + (size_t)l * 1024 * FFNH, FFNH, p.WguT + (size_t)l * 5632 * 1024, 1024, nt * 32, kt * 128, nt * 64 + 32, smem); }
    else { ti -= 2312; int nt = ti / 22, kt = ti % 22;
      transpose_tile(p.w_fd + (size_t)l * FFNH * 1024, 1024, p.WdT + (size_t)l * 1024 * FFNH, FFNH, nt * 32, kt * 128, nt * 32, smem, FFNH); }
  } else if (item < PREP_T + PREP_MOD) {
    int mi = item - PREP_T; int l = mi / 96, cb = mi % 96;
    float* sv = (float*)smem;
    float* red = sv + 9 * 1024;
    for (int idx = tid; idx < 9216; idx += 256) { int m = idx >> 10, k = idx & 1023; float v = m < 8 ? p.c[m * 1024 + k] : p.c_ctx[k]; sv[idx] = v / (1.f + expf(-v)); }
    __syncthreads();
    int kp = tid >> 6, col = tid & 63; float acc[9];
#pragma unroll
    for (int m = 0; m < 9; ++m) acc[m] = 0.f;
    const float* wp = p.w_ada + ((size_t)l * 1024 + kp * 256) * 6144 + cb * 64 + col;
#pragma unroll 16
    for (int k = 0; k < 256; ++k) { float wv = wp[(size_t)k * 6144];
#pragma unroll
      for (int m = 0; m < 9; ++m) acc[m] += sv[m * 1024 + kp * 256 + k] * wv; }
#pragma unroll
    for (int m = 0; m < 9; ++m) red[(kp * 9 + m) * 64 + col] = acc[m];
    __syncthreads();
    for (int idx = tid; idx < 576; idx += 256) { int m = idx >> 6, cc = idx & 63;
      float s = red[(0 * 9 + m) * 64 + cc] + red[(1 * 9 + m) * 64 + cc] + red[(2 * 9 + m) * 64 + cc] + red[(3 * 9 + m) * 64 + cc] + p.b_ada[l * 6144 + cb * 64 + cc];
      p.MOD[((size_t)l * 9 + m) * 6144 + cb * 64 + cc] = s; }
    __syncthreads();
  } else {
    if (tid < 64) { int pos = tid;
      for (int f = 0; f < 8; ++f) { float inv = exp2f(-(float)f / 8.f * 13.287712379549449f); float a = (float)pos * inv; p.TAB32[(pos * 8 + f) * 2] = cosf(a); p.TAB32[(pos * 8 + f) * 2 + 1] = sinf(a); }
      for (int f = 0; f < 16; ++f) { float inv = exp2f(-(float)f / 16.f * 13.287712379549449f); float a = (float)pos * inv; p.TAB64[(pos * 16 + f) * 2] = cosf(a); p.TAB64[(pos * 16 + f) * 2 + 1] = sinf(a); }
    }
    if (tid >= 64 && tid < 68) { int l = tid - 64; const float* d = p.dlam + l * 128; float s1 = 0.f, s2 = 0.f;
      for (int i = 0; i < 32; ++i) { s1 += d[i] * d[32 + i]; s2 += d[64 + i] * d[96 + i]; }
      float li = 0.8f - 0.6f * expf(-0.3f * (float)l);
      p.LAM[l * 2] = expf(s1) - expf(s2) + li; p.LAM[l * 2 + 1] = li; }
  }
}

__device__ void rowpass_row(const Params& p, int layer, int sub, int row, int lane) {
  const int b = row / TPB, tin = row % TPB; const bool isctx = tin < CTXL;
  const bool first = (layer == 0 && sub == 0);
  if (layer == DEPTH - 1 && sub == 1 && isctx) return;
  const float* src = first ? (isctx ? p.ctx + ((size_t)b * CTXL + tin) * DM : p.x + ((size_t)b * SEQL + (tin - CTXL)) * DM) : p.Z + (size_t)row * DM;
  f32x4 v[4];
#pragma unroll
  for (int i = 0; i < 4; ++i) v[i] = *(const f32x4*)(src + (i >> 1) * 512 + lane * 8 + (i & 1) * 4);
  if (!first) {
    float s = 0.f;
#pragma unroll
    for (int i = 0; i < 4; ++i) s += (v[i][0] + v[i][1]) + (v[i][2] + v[i][3]);
    const float mean = wave_sum(s) * (1.f / 1024.f);
    float q = 0.f;
#pragma unroll
    for (int i = 0; i < 4; ++i) { f32x4 d = v[i] - mean; q += (d[0] * d[0] + d[1] * d[1]) + (d[2] * d[2] + d[3] * d[3]); }
    const float rstd = rsqrtf(wave_sum(q) * (1.f / 1024.f) + 1e-6f);
    if (lane == 0) { p.ST[row * 2] = mean; p.ST[row * 2 + 1] = rstd; }
    const int gl = sub == 0 ? (layer - 1) * 2 + 1 : layer * 2;
    const float* g = p.ln_g + (size_t)gl * DM; const float* bb = p.ln_b + (size_t)gl * DM;
#pragma unroll
    for (int i = 0; i < 4; ++i) { f32x4 gv = *(const f32x4*)(g + (i >> 1) * 512 + lane * 8 + (i & 1) * 4), bv = *(const f32x4*)(bb + (i >> 1) * 512 + lane * 8 + (i & 1) * 4); v[i] = (v[i] - mean) * rstd * gv + bv; }
  } else {
    if (lane == 0) { p.ST[row * 2] = 0.f; p.ST[row * 2 + 1] = 1.f; }
#pragma unroll
    for (int i = 0; i < 4; ++i) *(f32x4*)(p.Z + (size_t)row * DM + (i >> 1) * 512 + lane * 8 + (i & 1) * 4) = v[i];
  }
  if (layer == DEPTH) {
    float fac = 1.f;
#if MEGA
#endif
    if (!isctx) { float* o = p.out + ((size_t)b * SEQL + (tin - CTXL)) * DM;
#pragma unroll
      for (int i = 0; i < 4; ++i) *(f32x4*)(o + (i >> 1) * 512 + lane * 8 + (i & 1) * 4) = v[i] * fac; }
    return;
  }
  float s = 0.f;
#pragma unroll
  for (int i = 0; i < 4; ++i) s += (v[i][0] + v[i][1]) + (v[i][2] + v[i][3]);
  const float mean2 = wave_sum(s) * (1.f / 1024.f);
  float q = 0.f;
#pragma unroll
  for (int i = 0; i < 4; ++i) { f32x4 d = v[i] - mean2; q += (d[0] * d[0] + d[1] * d[1]) + (d[2] * d[2] + d[3] * d[3]); }
  const float rstd2 = rsqrtf(wave_sum(q) * (1.f / 1024.f) + 1e-6f);
  const int msel = isctx ? 8 : b;
  const float* md = p.MOD + ((size_t)layer * 9 + msel) * 6144;
  const float* sh = md + (sub ? 3 : 0) * DM; const float* sc = md + (sub ? 4 : 1) * DM;
#pragma unroll
  for (int i2 = 0; i2 < 2; ++i2) { unsigned w4[4];
#pragma unroll
    for (int h = 0; h < 2; ++h) { const int i = i2 * 2 + h; const int co = i2 * 512 + lane * 8 + h * 4;
      f32x4 shv = *(const f32x4*)(sh + co), scv = *(const f32x4*)(sc + co);
      f32x4 u = (v[i] - mean2) * rstd2 * (scv + 1.f) + shv;
      w4[h * 2] = pk_bf16(u[0], u[1]); w4[h * 2 + 1] = pk_bf16(u[2], u[3]); }
    u32x4 wv = {w4[0], w4[1], w4[2], w4[3]};
    *(u32x4*)(p.U + (size_t)row * DM + i2 * 512 + lane * 8) = wv; }
}

__device__ void rowpass_item(const Params& p, int layer, int sub, int item) {
  const int tid = otid(); const int w = tid >> 6, lane = tid & 63;
#pragma unroll
  for (int i = 0; i < 4; ++i) rowpass_row(p, layer, sub, item * 16 + w * 4 + i, lane);
}

constexpr int GLS = 40;
enum { G_INPROJ = 0, G_OUTPROJ = 1, G_FFNUP = 2, G_FFNDOWN = 3 };

template <int MODE>
__device__ void gemm_item(const Params& p, int layer, int xcd, int q, char* smem) {
  constexpr int NTN = MODE == G_INPROJ ? 21 : (MODE == G_FFNUP ? 44 : 8);
  constexpr int K = MODE == G_FFNDOWN ? FFNH : DM;
  constexpr int BM = (MODE == G_INPROJ || MODE == G_FFNUP) ? 256 : 128;
  constexpr int MI = BM / 64, BAND = 4352 / BM, STRIP = BAND * 8;
  constexpr int NS = NTN / 8, REM = NTN % 8;
  const int sidx = q / STRIP; const int sw = sidx < NS ? 8 : REM; const int base = (sidx < NS ? sidx : NS) * STRIP; const int c0 = (sidx < NS ? sidx : NS) * 8;
  const int mt = BAND * xcd + (q - base) / sw, nt = c0 + (q - base) % sw; const int m0 = mt * BM, n0 = nt * 128;
  if (MODE != G_INPROJ && layer == DEPTH - 1 && (m0 % TPB) < CTXL) return;
  const bf16* A; const bf16* Bt; int lda = K, ldb = K;
  if (MODE == G_INPROJ) { A = p.U; Bt = p.WinT + (size_t)layer * WIN_ROWS * DM; }
  else if (MODE == G_OUTPROJ) { A = p.MIX; Bt = p.WoT + (size_t)layer * DM * DM; }
  else if (MODE == G_FFNUP) { A = p.U; Bt = p.WguT + (size_t)layer * 5632 * DM; }
  else { A = p.HID; Bt = p.WdT + (size_t)layer * DM * FFNH; }
  const int tid = otid(), lane = tid & 63, w = tid >> 6, wm = w >> 1, wn = w & 1, l31 = lane & 31, lh = lane >> 5;
  constexpr int BK = 64, LS = 72, NA = BM / 32;
  bf16* sA = (bf16*)smem; bf16* sB = sA + BM * LS;
  const int r0 = tid >> 3, kc = (tid & 7) * 8;
  const bf16* a0 = A + (size_t)(m0 + r0) * lda + kc; const bf16* b0 = Bt + (size_t)(n0 + r0) * ldb + kc;
  const size_t a32 = (size_t)32 * lda, b32 = (size_t)32 * ldb;
  const int so0 = r0 * LS + kc;
  u32x4 sa[NA], sb[4];
#define G_LOAD(KT) do { const int ko_ = (KT) * BK; _Pragma("unroll") for (int u = 0; u < NA; ++u) sa[u] = *(const u32x4*)(a0 + u * a32 + ko_); _Pragma("unroll") for (int u = 0; u < 4; ++u) sb[u] = *(const u32x4*)(b0 + u * b32 + ko_); } while (0)
#define G_STORE() do { _Pragma("unroll") for (int u = 0; u < NA; ++u) *(u32x4*)(sA + so0 + u * 32 * LS) = sa[u]; _Pragma("unroll") for (int u = 0; u < 4; ++u) *(u32x4*)(sB + so0 + u * 32 * LS) = sb[u]; } while (0)
#define G_COMPUTE() do { const bf16* cA = sA + (wm * (BM / 2) + l31) * LS + lh * 8; const bf16* cB = sB + (wn * 64 + l31) * LS + lh * 8; \
    _Pragma("unroll") for (int ks = 0; ks < 4; ++ks) { bf16x8 af[MI], bfr[2]; \
      _Pragma("unroll") for (int i = 0; i < MI; ++i) af[i] = *(const bf16x8*)(cA + i * 32 * LS + ks * 16); \
      _Pragma("unroll") for (int jj = 0; jj < 2; ++jj) bfr[jj] = *(const bf16x8*)(cB + jj * 32 * LS + ks * 16); \
      _Pragma("unroll") for (int i = 0; i < MI; ++i) _Pragma("unroll") for (int jj = 0; jj < 2; ++jj) acc[i][jj] = MFMA32(af[i], bfr[jj], acc[i][jj]); } } while (0)
  f32x16 acc[MI][2];
#pragma unroll
  for (int i = 0; i < MI; ++i)
#pragma unroll
    for (int jj = 0; jj < 2; ++jj)
#pragma unroll
      for (int r = 0; r < 16; ++r) acc[i][jj][r] = 0.f;
  constexpr int NK = K / BK;
  if (BM == 128) {
    const bf16* bp = Bt + ((size_t)((n0 + wn * 64) >> 5) * (K / 16)) * 512 + lane * 8;
    constexpr size_t NT_STRIDE = (size_t)(K / 16) * 512;
    bf16x8 b0s[2][4], b1s[2][4];
#define GB_LOAD(DST, KT) do { _Pragma("unroll") for (int jj = 0; jj < 2; ++jj) _Pragma("unroll") for (int ks = 0; ks < 4; ++ks) DST[jj][ks] = *(const bf16x8*)(bp + jj * NT_STRIDE + (size_t)((KT) * 4 + ks) * 512); } while (0)
#define GA_LOAD(KT) do { const int ko_ = (KT) * BK; _Pragma("unroll") for (int u = 0; u < NA; ++u) sa[u] = *(const u32x4*)(a0 + u * a32 + ko_); } while (0)
#define GA_STORE(BUF) do { _Pragma("unroll") for (int u = 0; u < NA; ++u) *(u32x4*)(sA + (BUF) * BM * LS + so0 + u * 32 * LS) = sa[u]; } while (0)
#define GB_COMPUTE(BS, BUF) do { const bf16* cA = sA + (BUF) * BM * LS + (wm * (BM / 2) + l31) * LS + lh * 8; \
    _Pragma("unroll") for (int ks = 0; ks < 4; ++ks) { bf16x8 af[MI]; \
      _Pragma("unroll") for (int i = 0; i < MI; ++i) af[i] = *(const bf16x8*)(cA + i * 32 * LS + ks * 16); \
      _Pragma("unroll") for (int i = 0; i < MI; ++i) _Pragma("unroll") for (int jj = 0; jj < 2; ++jj) acc[i][jj] = MFMA32(af[i], BS[jj][ks], acc[i][jj]); } } while (0)
    GA_LOAD(0); GB_LOAD(b0s, 0);
    GA_STORE(0);
    __syncthreads();
#pragma unroll 1
    for (int kt = 0; kt < NK; kt += 2) {
      GA_LOAD(kt + 1); GB_LOAD(b1s, kt + 1);
      asm volatile("" ::: "memory");
      GB_COMPUTE(b0s, 0);
      GA_STORE(1);
      __syncthreads();
      GA_LOAD((kt + 2 < NK ? kt + 2 : NK - 1)); GB_LOAD(b0s, (kt + 2 < NK ? kt + 2 : NK - 1));
      asm volatile("" ::: "memory");
      GB_COMPUTE(b1s, 1);
      GA_STORE(0);
      __syncthreads();
    }
#undef GB_LOAD
#undef GA_LOAD
#undef GA_STORE
#undef GB_COMPUTE
  } else {
  G_LOAD(0);
  G_STORE();
  __syncthreads();
#pragma unroll 1
  for (int kt = 0; kt < NK; ++kt) {
    G_LOAD((kt + 1 < NK ? kt + 1 : NK - 1));
    asm volatile("" ::: "memory");
    G_COMPUTE();
    __syncthreads();
    G_STORE();
    __syncthreads();
  }
  }
#undef G_LOAD
#undef G_STORE
#undef G_COMPUTE
  const int bidx = m0 / TPB, tin0 = m0 % TPB; const bool ctxtile = tin0 < CTXL; const int msel = ctxtile ? 8 : bidx;
  if (MODE == G_OUTPROJ || MODE == G_FFNDOWN) {
    const float* gate = p.MOD + ((size_t)layer * 9 + msel) * 6144 + (MODE == G_OUTPROJ ? 2 : 5) * DM;
    const bool haveln = !(MODE == G_OUTPROJ && layer == 0);
    const int gl = MODE == G_OUTPROJ ? (layer - 1) * 2 + 1 : layer * 2;
    const float* g = p.ln_g + (size_t)(haveln ? gl : 0) * DM; const float* bb = p.ln_b + (size_t)(haveln ? gl : 0) * DM;
    const int col0 = n0 + wn * 64 + l31;
    const float gt0 = gate[col0], gt1 = gate[col0 + 32];
    const float gv0 = haveln ? g[col0] : 1.f, gv1 = haveln ? g[col0 + 32] : 1.f, bv0 = haveln ? bb[col0] : 0.f, bv1 = haveln ? bb[col0 + 32] : 0.f;
#pragma unroll
    for (int i = 0; i < MI; ++i)
#pragma unroll
      for (int r = 0; r < 16; ++r) {
        const int row = m0 + wm * (BM / 2) + i * 32 + crow(r, lh);
        float* zp = p.Z + (size_t)row * DM + col0;
        const float mean = p.ST[row * 2], rstd = p.ST[row * 2 + 1];
        const float h0 = (zp[0] - mean) * rstd * gv0 + bv0, h1 = (zp[32] - mean) * rstd * gv1 + bv1;
        zp[0] = DN_ALPHA * h0 + gt0 * acc[i][0][r];
        zp[32] = DN_ALPHA * h1 + gt1 * acc[i][1][r];
        if (r == 15) asm volatile("" ::: "memory");
      }
  } else if (MODE == G_FFNUP) {
    bf16* sH = (bf16*)smem;
#pragma unroll
    for (int i = 0; i < MI; ++i)
#pragma unroll
      for (int r = 0; r < 16; ++r) {
        const float gg = acc[i][0][r], uu = acc[i][1][r];
        const float hv = gg * __builtin_amdgcn_rcpf(1.f + __expf(-gg)) * uu;
        sH[(wm * (BM / 2) + i * 32 + crow(r, lh)) * 72 + wn * 32 + l31] = f2bf(hv);
      }
    __syncthreads();
#pragma unroll
    for (int u = 0; u < BM / 32; ++u) { const int it = tid + 256 * u; const int row = it >> 3, ch = it & 7;
      *(u32x4*)(p.HID + (size_t)(m0 + row) * FFNH + n0 / 2 + ch * 8) = *(const u32x4*)(sH + row * 72 + ch * 8); }
    __syncthreads();
  } else {
    float* sC = (float*)smem;
    int mode, dcol = 0; float scale = 1.f; bf16* xt = nullptr; int xcols = 0, xcb = 0;
    if (nt < 2) { mode = 0; scale = 0.125f; dcol = PC_GQ + nt * 128; }
    else if (nt < 4) { mode = 0; dcol = PC_GK + (nt - 2) * 128; }
    else if (nt < 6) { mode = 3; xt = p.GVt; xcols = 256; xcb = (nt - 4) * 128; }
    else if (nt < 8) { mode = 0; dcol = PC_GO + (nt - 6) * 128; }
    else if (nt < 10) { mode = 1; scale = 0.17677669529663687f * 1.4426950408889634f; dcol = PC_DQ + (nt - 8) * 128; }
    else if (nt < 12) { mode = 1; dcol = PC_DK + (nt - 10) * 128; }
    else if (nt < 14) { mode = 3; xt = p.DVt; xcols = 256; xcb = (nt - 12) * 128; }
    else if (nt < 18) { mode = 2; scale = 0.125f * 1.4426950408889634f; dcol = PC_SQ + (nt - 14) * 128; }
    else if (nt < 19) { mode = 2; dcol = PC_SK; }
    else if (nt < 20) { mode = 3; xt = p.SVt; xcols = 128; xcb = 0; }
    else mode = 4;
    const int cs = mode == 3 ? 133 : 132;
#pragma unroll
    for (int half = 0; half < BM / 64; ++half) {
      if (wm == half / (MI / 2)) {
#pragma unroll
        for (int i = 0; i < 2; ++i)
#pragma unroll
          for (int j = 0; j < 2; ++j)
#pragma unroll
            for (int r = 0; r < 16; ++r) sC[(i * 32 + crow(r, lh)) * cs + wn * 64 + j * 32 + l31] = acc[(half % (MI / 2)) * 2 + i][j][r];
      }
      __syncthreads();
      if (mode <= 2) {
        for (int it = tid; it < 1024; it += 256) {
          const int row = it >> 4, cg8 = (it & 15) * 8; const int tin = tin0 + half * 64 + row; const size_t token = (size_t)m0 + half * 64 + row;
          float v[8];
          { const f32x4 v0 = *(const f32x4*)(sC + row * cs + cg8), v1 = *(const f32x4*)(sC + row * cs + cg8 + 4);
#pragma unroll
            for (int e = 0; e < 4; ++e) { v[e] = v0[e]; v[4 + e] = v1[e]; } }
          if (mode != 0 && !ctxtile) {
            const int dimh = mode == 1 ? 16 : 32; const int d = cg8 & (2 * dimh - 1); const bool second = d >= dimh; const int pi0 = second ? d - dimh : d;
            const int pcol = second ? cg8 - dimh : cg8 + dimh; const int nf = dimh >> 1; const bool usecol = pi0 >= nf; const int f0 = usecol ? pi0 - nf : pi0;
            const int pos = tin - CTXL; const int ps = usecol ? (pos & 63) : (pos >> 6);
            const float* tb = (mode == 1 ? p.TAB32 + (ps * 8 + f0) * 2 : p.TAB64 + (ps * 16 + f0) * 2);
            const f32x4 w0 = *(const f32x4*)(sC + row * cs + pcol), w1 = *(const f32x4*)(sC + row * cs + pcol + 4);
#pragma unroll
            for (int e2 = 0; e2 < 4; ++e2) { const f32x4 t4 = *(const f32x4*)(tb + e2 * 4);
#pragma unroll
              for (int h2 = 0; h2 < 2; ++h2) { const int e = e2 * 2 + h2; const float wv = e < 4 ? w0[e & 3] : w1[e & 3]; const float co = t4[h2 * 2], sn = t4[h2 * 2 + 1];
                v[e] = second ? (wv * sn + v[e] * co) : (v[e] * co - wv * sn); } }
          }
          u32x4 wv = {pk_bf16(v[0] * scale, v[1] * scale), pk_bf16(v[2] * scale, v[3] * scale), pk_bf16(v[4] * scale, v[5] * scale), pk_bf16(v[6] * scale, v[7] * scale)};
          *(u32x4*)(p.P + token * PW + dcol + cg8) = wv;
        }
      } else if (mode == 3) {
        for (int it = tid; it < 1024; it += 256) {
          const int col = it >> 3, g8 = it & 7; float v[8];
#pragma unroll
          for (int e = 0; e < 8; ++e) v[e] = sC[(g8 * 8 + e) * cs + col];
          u32x4 wv = {pk_bf16(v[0], v[1]), pk_bf16(v[2], v[3]), pk_bf16(v[4], v[5]), pk_bf16(v[6], v[7])};
          *(u32x4*)(xt + ((size_t)bidx * xcols + xcb + col) * TPB + tin0 + half * 64 + g8 * 8) = wv;
        }
      } else {
        for (int it = tid; it < 512; it += 256) { const int row = it >> 3, c4 = (it & 7) * 4; const size_t token = (size_t)m0 + half * 64 + row;
          const f32x4 o = *(const f32x4*)(sC + row * cs + c4);
          *(f32x4*)(p.GZ + token * 32 + c4) = o; }
      }
      __syncthreads();
    }
  }
}

constexpr int TS = 72;
__device__ __forceinline__ f32x16 nt64(const bf16* sA, const bf16* sB, f32x16 acc) {
  const int tid = otid(); const int lane = tid & 63, w = tid >> 6, wi = w >> 1, wj = w & 1, l31 = lane & 31, lh = lane >> 5;
#pragma unroll
  for (int ks = 0; ks < 4; ++ks) {
    bf16x8 a = *(const bf16x8*)(sA + (wi * 32 + l31) * TS + ks * 16 + lh * 8);
    bf16x8 b = *(const bf16x8*)(sB + (wj * 32 + l31) * TS + ks * 16 + lh * 8);
    acc = MFMA32(a, b, acc);
  }
  return acc;
}

__device__ void gla_cumgate(const Params& p, int layer, int h, int dir, const float* sz, float* sb, float* stot) {
  const int tid = otid(), qtr = tid >> 6, k = tid & 63;
  const float* W = p.w_gg + ((size_t)(layer * 2 + dir) * 16) * 256 + h * 64 + k;
  float wv[16];
#pragma unroll
  for (int r = 0; r < 16; ++r) wv[r] = W[r * 256];
  const float bias = p.b_gg[(layer * 2 + dir) * 256 + h * 64 + k];
  float cum = 0.f;
#pragma unroll 4
  for (int i = 0; i < 16; ++i) {
    const int t = dir == 0 ? qtr * 16 + i : qtr * 16 + 15 - i;
    float z = bias;
    { const f32x4* zr = (const f32x4*)(sz + t * 32 + dir * 16);
#pragma unroll
      for (int r4 = 0; r4 < 4; ++r4) { const f32x4 zv = zr[r4]; z += zv[0] * wv[4 * r4] + zv[1] * wv[4 * r4 + 1] + zv[2] * wv[4 * r4 + 2] + zv[3] * wv[4 * r4 + 3]; } }
    const float ls = fminf(z, 0.f) - __builtin_amdgcn_logf(1.f + __builtin_amdgcn_exp2f(-fabsf(z) * 1.4426950408889634f)) * 0.6931471805599453f;
    cum += ls * 0.0625f;
    sb[t * 65 + k] = cum;
  }
  stot[qtr * 64 + k] = cum;
  __syncthreads();
  float off = 0.f;
#pragma unroll
  for (int q = 0; q < 4; ++q) if (dir == 0 ? q < qtr : q > qtr) off += stot[q * 64 + k];
#pragma unroll 4
  for (int i = 0; i < 16; ++i) sb[(qtr * 16 + i) * 65 + k] += off;
  __syncthreads();
}

constexpr int L_SB = 0, L_T0 = 16640, L_TSZ = 64 * TS * 2  ;

__device__ void gla_load_common(const Params& p, int b, int h, int chunk, float* sz, bf16* sVt) {
  const int tid = otid(); const size_t token0 = (size_t)b * TPB + chunk * 64;
#pragma unroll
  for (int i = 0; i < 8; ++i) { int it = tid + 256 * i; sz[it] = p.GZ[token0 * 32 + it]; }
#pragma unroll
  for (int i = 0; i < 2; ++i) { int it = tid + 256 * i; int dv = it >> 3, ch = it & 7;
    *(u32x4*)(sVt + dv * TS + ch * 8) = *(const u32x4*)(p.GVt + ((size_t)b * 256 + h * 64 + dv) * TPB + chunk * 64 + ch * 8); }
}

__device__ void gla_g1_item(const Params& p, int layer, int item, char* smem) {
  const int chunk = item % NCHUNK, bh = item / NCHUNK, b = bh >> 2, h = bh & 3;
  const int tid = otid(), lane = tid & 63, w = tid >> 6, wi = w >> 1, wj = w & 1, l31 = lane & 31, lh = lane >> 5;
  float* sb = (float*)(smem + L_SB);
  bf16* sKh = (bf16*)(smem + L_T0); bf16* sVt = (bf16*)(smem + L_T0 + L_TSZ); float* sz = (float*)(smem + L_T0 + 2 * L_TSZ); float* stot = (float*)(smem + L_T0 + 2 * L_TSZ + 8192);
  const size_t token0 = (size_t)b * TPB + chunk * 64;
  __syncthreads();
  gla_load_common(p, b, h, chunk, sz, sVt);
  __syncthreads();
  for (int dir = 0; dir < 2; ++dir) {
    gla_cumgate(p, layer, h, dir, sz, sb, stot);
    const int bend = dir == 0 ? 63 : 0; const int bhd = bh * 2 + dir;
    { const int s = tid & 63, dkg = tid >> 6;
      const u32x4* kp = (const u32x4*)(p.P + (token0 + s) * PW + PC_GK + h * 64 + dkg * 16);
      u32x4 k0 = kp[0], k1 = kp[1]; float kv[16];
#pragma unroll
      for (int e = 0; e < 4; ++e) { kv[2 * e] = bflo(k0[e]); kv[2 * e + 1] = bfhi(k0[e]); kv[8 + 2 * e] = bflo(k1[e]); kv[8 + 2 * e + 1] = bfhi(k1[e]); }
#pragma unroll
      for (int e = 0; e < 16; ++e) { const int dk = dkg * 16 + e; sKh[dk * TS + s] = f2bf(kv[e] * __expf(sb[bend * 65 + dk] - sb[s * 65 + dk])); } }
    if (tid < 64) p.DEC[((size_t)bhd * NCHUNK + chunk) * 64 + tid] = __expf(sb[bend * 65 + tid]);
    __syncthreads();
    f32x16 acc;
#pragma unroll
    for (int r = 0; r < 16; ++r) acc[r] = 0.f;
    acc = nt64(sVt, sKh, acc);
    float* dst = p.SlocT + ((size_t)bhd * NCHUNK + chunk) * 4096;
#pragma unroll
    for (int r = 0; r < 16; ++r) dst[(wi * 32 + crow(r, lh)) * 64 + wj * 32 + l31] = acc[r];
    __syncthreads();
  }
}

__device__ void gla_g2_item(const Params& p, int item) {
  const int bhd = item >> 2, part = item & 3, dir = bhd & 1; const int tid = otid();
  const int e = part * 1024 + tid * 4, dk = e & 63;
  const float* sl = p.SlocT + (size_t)bhd * NCHUNK * 4096 + e; const float* dc = p.DEC + (size_t)bhd * NCHUNK * 64 + dk; bf16* sp = p.Sprev + (size_t)bhd * NCHUNK * 4096 + e;
  float z0 = 0.f; asm volatile("" : "+v"(z0));
  f32x4 S = {z0, z0, z0, z0};
  int c = dir == 0 ? 0 : 3;
  f32x4 nsl = *(const f32x4*)(sl + (size_t)c * 4096), ndc = *(const f32x4*)(dc + c * 64);
  for (int s = 0; s < NCHUNK; ++s) {
    const f32x4 csl = nsl, cdc = ndc; const int cc = c;
    if (s + 1 < NCHUNK) { const int s1 = s + 1; c = dir == 0 ? s1 : (s1 < 4 ? 3 - s1 : 71 - s1); nsl = *(const f32x4*)(sl + (size_t)c * 4096); ndc = *(const f32x4*)(dc + c * 64); }
    u32x2 wv = {pk_bf16(S[0], S[1]), pk_bf16(S[2], S[3])};
    *(u32x2*)(sp + (size_t)cc * 4096) = wv;
    S = cdc * S + csl;
  }
}

__device__ void gla_g3_item(const Params& p, int layer, int item, char* smem) {
  const int chunk = item % NCHUNK, bh = item / NCHUNK, b = bh >> 2, h = bh & 3;
  const int tid = otid(), lane = tid & 63, w = tid >> 6, wi = w >> 1, wj = w & 1, l31 = lane & 31, lh = lane >> 5;
  float* sb = (float*)(smem + L_SB);
  bf16* sQ = (bf16*)(smem + L_T0); bf16* sK = (bf16*)(smem + L_T0 + L_TSZ); bf16* sVt = (bf16*)(smem + L_T0 + 2 * L_TSZ); bf16* sS = (bf16*)(smem + L_T0 + 3 * L_TSZ);
  bf16* sAT = sK; float* sz = (float*)sS; float* stot = (float*)sQ; float* so = sb;
  const size_t token0 = (size_t)b * TPB + chunk * 64;
  __syncthreads();
  gla_load_common(p, b, h, chunk, sz, sVt);
  __syncthreads();
  f32x16 att, acc;
#pragma unroll
  for (int r = 0; r < 16; ++r) { att[r] = 0.f; acc[r] = 0.f; }
  for (int dir = 0; dir < 2; ++dir) {
    if (dir == 1) {
#pragma unroll
      for (int i = 0; i < 8; ++i) { int it = tid + 256 * i; sz[it] = p.GZ[token0 * 32 + it]; }
      __syncthreads(); }
    gla_cumgate(p, layer, h, dir, sz, sb, stot);
    const int bhd = bh * 2 + dir;
    { const int t = tid >> 2, kg = (tid & 3) * 16;
      const u32x4* qp = (const u32x4*)(p.P + (token0 + t) * PW + PC_GQ + h * 64 + kg);
      const u32x4* kp = (const u32x4*)(p.P + (token0 + t) * PW + PC_GK + h * 64 + kg);
      u32x4 q0 = qp[0], q1 = qp[1], k0 = kp[0], k1 = kp[1]; unsigned qo[8], ko[8];
#pragma unroll
      for (int e = 0; e < 8; ++e) { const unsigned qw = e < 4 ? q0[e] : q1[e - 4], kw = e < 4 ? k0[e] : k1[e - 4];
        const float b0 = sb[t * 65 + kg + 2 * e], b1 = sb[t * 65 + kg + 2 * e + 1];
        qo[e] = pk_bf16(bflo(qw) * __expf(b0), bfhi(qw) * __expf(b1)); ko[e] = pk_bf16(bflo(kw) * __expf(-b0), bfhi(kw) * __expf(-b1)); }
      u32x4 w0 = {qo[0], qo[1], qo[2], qo[3]}, w1 = {qo[4], qo[5], qo[6], qo[7]}, w2 = {ko[0], ko[1], ko[2], ko[3]}, w3 = {ko[4], ko[5], ko[6], ko[7]};
      *(u32x4*)(sQ + t * TS + kg) = w0; *(u32x4*)(sQ + t * TS + kg + 8) = w1; *(u32x4*)(sK + t * TS + kg) = w2; *(u32x4*)(sK + t * TS + kg + 8) = w3; }
#pragma unroll
    for (int i = 0; i < 2; ++i) { int it = tid + 256 * i; int dv = it >> 3, ch = it & 7;
      *(u32x4*)(sS + dv * TS + ch * 8) = *(const u32x4*)(p.Sprev + ((size_t)bhd * NCHUNK + chunk) * 4096 + dv * 64 + ch * 8); }
    __syncthreads();
    f32x16 a;
#pragma unroll
    for (int r = 0; r < 16; ++r) a[r] = 0.f;
    a = nt64(sQ, sK, a);
#pragma unroll
    for (int r = 0; r < 16; ++r) { const int t = wi * 32 + crow(r, lh), s = wj * 32 + l31; const bool keep = dir == 0 ? (s <= t) : (s >= t); att[r] += keep ? a[r] : 0.f; }
    acc = nt64(sQ, sS, acc);
    __syncthreads();
  }
#pragma unroll
  for (int r = 0; r < 16; ++r) sAT[(wi * 32 + crow(r, lh)) * TS + wj * 32 + l31] = f2bf(att[r]);
  __syncthreads();
  acc = nt64(sAT, sVt, acc);
#pragma unroll
  for (int r = 0; r < 16; ++r) so[(wi * 32 + crow(r, lh)) * 65 + wj * 32 + l31] = acc[r];
  __syncthreads();
  { const int t = tid >> 2, part = tid & 3; float o[16]; float ss = 0.f;
#pragma unroll
    for (int e = 0; e < 16; ++e) { o[e] = so[t * 65 + part * 16 + e]; ss += o[e] * o[e]; }
    ss += __shfl_xor(ss, 1); ss += __shfl_xor(ss, 2);
    const float rn = rsqrtf(ss * (1.f / 64.f) + 1e-6f);
    const u32x4* gp = (const u32x4*)(p.P + (token0 + t) * PW + PC_GO + h * 64 + part * 16);
    u32x4 g0 = gp[0], g1 = gp[1]; unsigned ow[8]; const float* gn = p.gla_g + layer * 64 + part * 16;
#pragma unroll
    for (int e = 0; e < 8; ++e) { const unsigned gw = e < 4 ? g0[e] : g1[e - 4]; const float ga = bflo(gw), gb = bfhi(gw);
      const float y0 = o[2 * e] * rn * gn[2 * e] * (ga * __builtin_amdgcn_rcpf(1.f + __expf(-ga))), y1 = o[2 * e + 1] * rn * gn[2 * e + 1] * (gb * __builtin_amdgcn_rcpf(1.f + __expf(-gb)));
      ow[e] = pk_bf16(y0, y1); }
    u32x4 w0 = {ow[0], ow[1], ow[2], ow[3]}, w1 = {ow[4], ow[5], ow[6], ow[7]};
    bf16* dst = p.MIX + (token0 + t) * DM + h * 64 + part * 16;
    *(u32x4*)dst = w0; *(u32x4*)(dst + 8) = w1; }
  __syncthreads();
}

template <int DH>
__device__ void flash128(const bf16* Q, const bf16* K, const bf16* Vt, int s0a, int s0b, int s1a, int s1b, bool win, int qtok0, float m0, float l0, f32x16 (&O)[2], char* smem) {
  constexpr int KS = DH + 8; constexpr int NKC = DH / 32;
  const int tid = otid(), lane = tid & 63, w = tid >> 6, l31 = lane & 31, lh = lane >> 5;
  bf16* sK = (bf16*)smem; bf16* sV = sK + 64 * TS;
  bf16x8 qf[DH / 16];
  { const bf16* qp = Q + (size_t)(w * 32 + l31) * PW + lh * 8;
#pragma unroll
    for (int ks = 0; ks < DH / 16; ++ks) qf[ks] = *(const bf16x8*)(qp + ks * 16); }
  float m = m0, l = lh == 0 ? l0 : 0.f;
#pragma unroll
  for (int r = 0; r < 16; ++r) { O[0][r] = 0.f; O[1][r] = 0.f; }
  const int nt0 = (s0b - s0a) >> 6, nt1 = (s1b - s1a) >> 6, ntile = nt0 + nt1;
  u32x4 rk[NKC], rv[2];
  auto tstart = [&](int t) { return t < nt0 ? s0a + t * 64 : s1a + (t - nt0) * 64; };
  auto gload = [&](int t) { const int key0 = tstart(t);
#pragma unroll
    for (int i = 0; i < NKC; ++i) { int it = tid + 256 * i; int row = it / (DH / 8), ch = it % (DH / 8); rk[i] = *(const u32x4*)(K + (size_t)(key0 + row) * PW + ch * 8); }
#pragma unroll
    for (int i = 0; i < 2; ++i) { int it = tid + 256 * i; int dv = it >> 3, ch = it & 7; rv[i] = *(const u32x4*)(Vt + (size_t)dv * TPB + key0 + ch * 8); } };
  gload(0);
  for (int t = 0; t < ntile; ++t) {
    __syncthreads();
#pragma unroll
    for (int i = 0; i < NKC; ++i) { int it = tid + 256 * i; int row = it / (DH / 8), ch = it % (DH / 8); *(u32x4*)(sK + row * KS + ch * 8) = rk[i]; }
#pragma unroll
    for (int i = 0; i < 2; ++i) { int it = tid + 256 * i; int dv = it >> 3, ch = it & 7; *(u32x4*)(sV + dv * TS + ch * 8) = rv[i]; }
    __syncthreads();
    const int key0 = tstart(t); const bool domask = win && t >= nt0;
    if (t + 1 < ntile) gload(t + 1);
    f32x16 X[2];
#pragma unroll
    for (int kt2 = 0; kt2 < 2; ++kt2) {
#pragma unroll
      for (int r = 0; r < 16; ++r) X[kt2][r] = 0.f;
#pragma unroll
      for (int ks = 0; ks < DH / 16; ++ks) { bf16x8 a = *(const bf16x8*)(sK + (kt2 * 32 + l31) * KS + ks * 16 + lh * 8); X[kt2] = MFMA32(a, qf[ks], X[kt2]); }
    }
    if (domask) { const int qtok = qtok0 + w * 32 + l31;
#pragma unroll
      for (int kt2 = 0; kt2 < 2; ++kt2)
#pragma unroll
        for (int r = 0; r < 16; ++r) { const int d = key0 + kt2 * 32 + crow(r, lh) - qtok; if (d > 128 || d < -128) X[kt2][r] = -1e30f; } }
    float tmax = X[0][0];
#pragma unroll
    for (int r = 1; r < 16; ++r) tmax = fmaxf(tmax, X[0][r]);
#pragma unroll
    for (int r = 0; r < 16; ++r) tmax = fmaxf(tmax, X[1][r]);
    tmax = fmaxf(tmax, __shfl_xor(tmax, 32));
    if (!__all(tmax <= m + 8.f)) {
      const float mn = fmaxf(m, tmax); const float alpha = __builtin_amdgcn_exp2f(m - mn); m = mn; l *= alpha;
#pragma unroll
      for (int r = 0; r < 16; ++r) { O[0][r] *= alpha; O[1][r] *= alpha; }
    }
    X[0] = X[0] - m; X[1] = X[1] - m;
#pragma unroll
    for (int kt2 = 0; kt2 < 2; ++kt2)
#pragma unroll
      for (int r = 0; r < 16; ++r) X[kt2][r] = __builtin_amdgcn_exp2f(X[kt2][r]);
    { const f32x16 sv = X[0] + X[1]; float ps = 0.f;
#pragma unroll
      for (int r = 0; r < 16; ++r) ps += sv[r];
      l += ps; }
#pragma unroll
    for (int kt2 = 0; kt2 < 2; ++kt2)
#pragma unroll
      for (int s = 0; s < 2; ++s) {
        u32x4 pw = {pk_bf16(X[kt2][8 * s], X[kt2][8 * s + 1]), pk_bf16(X[kt2][8 * s + 2], X[kt2][8 * s + 3]), pk_bf16(X[kt2][8 * s + 4], X[kt2][8 * s + 5]), pk_bf16(X[kt2][8 * s + 6], X[kt2][8 * s + 7])};
        bf16x8 pb = *reinterpret_cast<bf16x8*>(&pw);
#pragma unroll
        for (int dt = 0; dt < 2; ++dt) {
          const bf16* vp = sV + (dt * 32 + l31) * TS + kt2 * 32 + s * 16 + lh * 4;
          u32x2 lo = *(const u32x2*)vp, hi = *(const u32x2*)(vp + 8);
          u32x4 vw = {lo[0], lo[1], hi[0], hi[1]};
          bf16x8 va = *reinterpret_cast<bf16x8*>(&vw);
          O[dt] = MFMA32(va, pb, O[dt]);
        }
      }
  }
  l += __shfl_xor(l, 32);
  const float inv = 1.f / l;
#pragma unroll
  for (int r = 0; r < 16; ++r) { O[0][r] *= inv; O[1][r] *= inv; }
}

__device__ __forceinline__ void store_ot(bf16* base  , const f32x16 (&O)[2]) {
  const int tid = otid(); const int lane = tid & 63, w = tid >> 6, l31 = lane & 31, lh = lane >> 5;
  bf16* rowp = base + (size_t)(w * 32 + l31) * DM;
#pragma unroll
  for (int dt = 0; dt < 2; ++dt)
#pragma unroll
    for (int g = 0; g < 4; ++g) { u32x2 wv = {pk_bf16(O[dt][4 * g], O[dt][4 * g + 1]), pk_bf16(O[dt][4 * g + 2], O[dt][4 * g + 3])};
      *(u32x2*)(rowp + dt * 32 + 8 * g + 4 * lh) = wv; }
}

__device__ void diff_item(const Params& p, int layer, int item, char* smem) {
  const int qb = 33 - item / 32, bh = item % 32, b = bh >> 2, h = bh & 3;
  const int tid = otid(), lane = tid & 63, w = tid >> 6, l31 = lane & 31, lh = lane >> 5;
  const bool isctx = qb < 2; const int ntile = (isctx ? CTXL : TPB) >> 6;
  if (isctx && layer == DEPTH - 1) return;
  const size_t qrow0 = (size_t)b * TPB + qb * 128;
  const bf16* K = p.P + (size_t)b * TPB * PW + PC_DK + h * 64; const bf16* Vt = p.DVt + ((size_t)b * 256 + h * 64) * TPB;
  bf16* sK = (bf16*)smem; bf16* sV = sK + 64 * TS;
  bf16x8 qf[2][2];
  { const bf16* qp = p.P + (qrow0 + w * 32 + l31) * PW + PC_DQ + h * 64 + lh * 8;
#pragma unroll
    for (int c = 0; c < 2; ++c)
#pragma unroll
      for (int ks = 0; ks < 2; ++ks) qf[c][ks] = *(const bf16x8*)(qp + c * 32 + ks * 16); }
  float m[2] = {-1e30f, -1e30f}, l[2] = {0.f, 0.f};
  f32x16 O[2][2];
#pragma unroll
  for (int c = 0; c < 2; ++c)
#pragma unroll
    for (int dt = 0; dt < 2; ++dt)
#pragma unroll
      for (int r = 0; r < 16; ++r) O[c][dt][r] = 0.f;
  u32x4 rk[2], rv[2];
  auto gload = [&](int t) { const int key0 = t * 64;
#pragma unroll
    for (int i = 0; i < 2; ++i) { int it = tid + 256 * i; int row = it >> 3, ch = it & 7; rk[i] = *(const u32x4*)(K + (size_t)(key0 + row) * PW + ch * 8); rv[i] = *(const u32x4*)(Vt + (size_t)row * TPB + key0 + ch * 8); } };
  gload(0);
  for (int t = 0; t < ntile; ++t) {
    __syncthreads();
#pragma unroll
    for (int i = 0; i < 2; ++i) { int it = tid + 256 * i; int row = it >> 3, ch = it & 7; *(u32x4*)(sK + row * TS + ch * 8) = rk[i]; *(u32x4*)(sV + row * TS + ch * 8) = rv[i]; }
    __syncthreads();
    if (t + 1 < ntile) gload(t + 1);
    u32x4 pw[2][2][2];
#pragma unroll
    for (int c = 0; c < 2; ++c) {
      f32x16 X[2];
#pragma unroll
      for (int kt2 = 0; kt2 < 2; ++kt2) {
#pragma unroll
        for (int r = 0; r < 16; ++r) X[kt2][r] = 0.f;
#pragma unroll
        for (int ks = 0; ks < 2; ++ks) { bf16x8 a = *(const bf16x8*)(sK + (kt2 * 32 + l31) * TS + c * 32 + ks * 16 + lh * 8); X[kt2] = MFMA32(a, qf[c][ks], X[kt2]); }
      }
      float tmax = X[0][0];
#pragma unroll
      for (int r = 1; r < 16; ++r) tmax = fmaxf(tmax, X[0][r]);
#pragma unroll
      for (int r = 0; r < 16; ++r) tmax = fmaxf(tmax, X[1][r]);
      tmax = fmaxf(tmax, __shfl_xor(tmax, 32));
      if (!__all(tmax <= m[c] + 8.f)) {
        const float mn = fmaxf(m[c], tmax); const float alpha = __builtin_amdgcn_exp2f(m[c] - mn); m[c] = mn; l[c] *= alpha;
#pragma unroll
        for (int r = 0; r < 16; ++r) { O[c][0][r] *= alpha; O[c][1][r] *= alpha; }
      }
      X[0] = X[0] - m[c]; X[1] = X[1] - m[c];
#pragma unroll
      for (int kt2 = 0; kt2 < 2; ++kt2)
#pragma unroll
        for (int r = 0; r < 16; ++r) X[kt2][r] = __builtin_amdgcn_exp2f(X[kt2][r]);
      { const f32x16 sv = X[0] + X[1]; float ps = 0.f;
#pragma unroll
        for (int r = 0; r < 16; ++r) ps += sv[r];
        l[c] += ps; }
#pragma unroll
      for (int kt2 = 0; kt2 < 2; ++kt2)
#pragma unroll
        for (int s2 = 0; s2 < 2; ++s2) {
          u32x4 t4 = {pk_bf16(X[kt2][8 * s2], X[kt2][8 * s2 + 1]), pk_bf16(X[kt2][8 * s2 + 2], X[kt2][8 * s2 + 3]), pk_bf16(X[kt2][8 * s2 + 4], X[kt2][8 * s2 + 5]), pk_bf16(X[kt2][8 * s2 + 6], X[kt2][8 * s2 + 7])};
          pw[c][kt2][s2] = t4; }
    }
#pragma unroll
    for (int kt2 = 0; kt2 < 2; ++kt2)
#pragma unroll
      for (int s2 = 0; s2 < 2; ++s2)
#pragma unroll
        for (int dt = 0; dt < 2; ++dt) {
          const bf16* vp = sV + (dt * 32 + l31) * TS + kt2 * 32 + s2 * 16 + lh * 4;
          u32x2 lo = *(const u32x2*)vp, hi = *(const u32x2*)(vp + 8);
          u32x4 vw = {lo[0], lo[1], hi[0], hi[1]};
          const bf16x8 va = __builtin_bit_cast(bf16x8, vw);
          O[0][dt] = MFMA32(va, __builtin_bit_cast(bf16x8, pw[0][kt2][s2]), O[0][dt]);
          O[1][dt] = MFMA32(va, __builtin_bit_cast(bf16x8, pw[1][kt2][s2]), O[1][dt]);
        }
  }
  const float l0 = l[0] + __shfl_xor(l[0], 32), l1 = l[1] + __shfl_xor(l[1], 32);
  const float lam = p.LAM[layer * 2], li = p.LAM[layer * 2 + 1];
  const float i0 = 1.f / l0, i1 = lam / l1;
  float ss = 0.f;
#pragma unroll
  for (int dt = 0; dt < 2; ++dt)
#pragma unroll
    for (int r = 0; r < 16; ++r) { const float o = O[0][dt][r] * i0 - O[1][dt][r] * i1; O[0][dt][r] = o; ss += o * o; }
  ss += __shfl_xor(ss, 32);
  const float rn = rsqrtf(ss * (1.f / 64.f) + 1e-6f) * (1.f - li);
  const float* g = p.diff_g + layer * 64;
#pragma unroll
  for (int dt = 0; dt < 2; ++dt)
#pragma unroll
    for (int r = 0; r < 16; ++r) O[0][dt][r] *= rn * g[dt * 32 + crow(r, lh)];
  store_ot(p.MIX + qrow0 * DM + 256 + h * 64, O[0]);
}

__device__ void swa_item(const Params& p, int layer, int item, char* smem) {
  const int qb = item / 64, bhh = item % 64, b = bhh >> 3, hh = bhh & 7, g = hh >> 2;
  const bool isctx = qb < 2; const size_t qrow0 = (size_t)b * TPB + qb * 128;
  if (isctx && layer == DEPTH - 1) return;
  const bf16* Kb = p.P + (size_t)b * TPB * PW + PC_SK + g * 64; const bf16* Vt = p.SVt + ((size_t)b * 128 + g * 64) * TPB;
  int s1a = 0, s1b = 0;
  if (!isctx) { const int i = qb - 2; int lo = 128 * (i - 1), hi = 128 * (i + 2); lo = lo < 0 ? 0 : lo; hi = hi > SEQL ? SEQL : hi; s1a = CTXL + lo; s1b = CTXL + hi; }
  f32x16 O[2];
  flash128<64>(p.P + qrow0 * PW + PC_SQ + hh * 64, Kb, Vt, 0, CTXL, s1a, s1b, true, qb * 128, p.sink[layer * 8 + hh] * 1.4426950408889634f, 1.f, O, smem);
  store_ot(p.MIX + qrow0 * DM + 512 + hh * 64, O);
}

enum { PH_PREP = 0, PH_ROW, PH_INPROJ, PH_M1, PH_M2, PH_G3, PH_OUTPROJ, PH_FFNUP, PH_FFNDOWN };
constexpr int N_G1 = NBATCH * 4 * NCHUNK  , N_SWA = 34 * 64  , N_G2 = 256, N_DIFF = 34 * 32  ;

template <int PH> __device__ __forceinline__ int phase_items() {
  return PH == PH_PREP ? PREP_ITEMS : PH == PH_ROW ? TTOK / 16 : PH == PH_INPROJ ? 272 * 21 : PH == PH_M1 ? N_G1 + N_SWA : PH == PH_M2 ? N_G2 + N_DIFF :
         PH == PH_G3 ? N_G1 : PH == PH_OUTPROJ ? 272 * 8 : PH == PH_FFNUP ? 272 * 44 : 272 * 8;
}
template <int PH> __device__ __forceinline__ void run_item(const Params& p, int layer, int sub, int item, char* smem) {
  if (PH == PH_PREP) prep_item(p, item, smem);
  else if (PH == PH_ROW) rowpass_item(p, layer, sub, item);
  else if (PH == PH_M1) { if (item < N_G1) gla_g1_item(p, layer, item, smem); else { __syncthreads(); swa_item(p, layer, item - N_G1, smem); } }
  else if (PH == PH_M2) { if (item < N_G2) gla_g2_item(p, item); else { __syncthreads(); diff_item(p, layer, item - N_G2, smem); } }
  else if (PH == PH_G3) gla_g3_item(p, layer, item, smem);
}
template <int PH> __device__ __forceinline__ void run_phase(const Params& p, int layer, int sub, char* smem) {
  if (PH == PH_INPROJ || PH == PH_OUTPROJ || PH == PH_FFNUP || PH == PH_FFNDOWN) {
    constexpr int NTN = PH == PH_INPROJ ? 21 : (PH == PH_FFNUP ? 44 : 8);
    const int nl = gridDim.x >> 3, xcd = blockIdx.x & 7;
    constexpr int BANDT = (PH == PH_INPROJ || PH == PH_FFNUP) ? 17 : 34;
    for (int q = blockIdx.x >> 3; q < BANDT * NTN; q += nl) {
      if (PH == PH_INPROJ) gemm_item<G_INPROJ>(p, layer, xcd, q, smem);
      else if (PH == PH_OUTPROJ) gemm_item<G_OUTPROJ>(p, layer, xcd, q, smem);
      else if (PH == PH_FFNUP) gemm_item<G_FFNUP>(p, layer, xcd, q, smem);
      else gemm_item<G_FFNDOWN>(p, layer, xcd, q, smem);
    }
    return;
  }
  const int n = phase_items<PH>();
  for (int item = blockIdx.x; item < n; item += gridDim.x) run_item<PH>(p, layer, sub, item, smem);
}

#ifndef B2MASK
#define B2MASK 0x1FF
#endif
template <int PH> __global__ void __launch_bounds__(256, ((B2MASK >> PH) & 1) ? 2 : 1) k_phase(Params p, int layer, int sub) {
  __shared__ __attribute__((aligned(16))) char smem[SMEM_BYTES];
  run_phase<PH>(p, layer, sub, smem);
}

__device__ __forceinline__ void grid_barrier(unsigned* bar, unsigned target) {
  asm volatile("s_waitcnt vmcnt(0)" ::: "memory");
  __syncthreads();
  if (threadIdx.x == 0) {
    __builtin_amdgcn_fence(__ATOMIC_RELEASE, "agent");
    asm volatile("s_waitcnt vmcnt(0)" ::: "memory");
    __hip_atomic_fetch_add(bar, 1u, __ATOMIC_RELAXED, __HIP_MEMORY_SCOPE_AGENT);
    const unsigned long long t0 = __builtin_amdgcn_s_memrealtime();
    while (__hip_atomic_load(bar, __ATOMIC_RELAXED, __HIP_MEMORY_SCOPE_AGENT) < target) {
      __builtin_amdgcn_s_sleep(1);
      if (__builtin_amdgcn_s_memrealtime() - t0 > 200000000ull) { __hip_atomic_store(bar + 32, 1u, __ATOMIC_RELAXED, __HIP_MEMORY_SCOPE_AGENT); break; }
    }
    __builtin_amdgcn_fence(__ATOMIC_ACQUIRE, "agent");
    asm volatile("s_waitcnt vmcnt(0)" ::: "memory");
  }
  __syncthreads();
}
#define GSYNC() do { nbar += 2; grid_barrier(p.BAR, (nbar - 1) * gridDim.x, nbar * gridDim.x); } while (0)
#define XB_TMO      128
#define XB_XCNT(j)  (256  + 64 * (j))
#define XB_XSUB(j)  (1280 + 64 * (j))
#define XB_XGEN(j)  (2304 + 64 * (j))
#define XB_TOP      3328
#define XB_TOPGEN   3392
#define XCD_BAR_WORDS 3456
#define XB_SPIN_CAP (1u << 18)
#define LAS __attribute__((address_space(3)))

__device__ __forceinline__ unsigned xb_ld(unsigned* p)              { return __hip_atomic_load(p, __ATOMIC_RELAXED, __HIP_MEMORY_SCOPE_AGENT); }
__device__ __forceinline__ unsigned xb_add(unsigned* p, unsigned v) { return __hip_atomic_fetch_add(p, v, __ATOMIC_RELAXED, __HIP_MEMORY_SCOPE_AGENT); }
__device__ __forceinline__ unsigned xb_xcc_id() { return (unsigned)__builtin_amdgcn_s_getreg((3 << 11) | 20) & 0xFu; }
#define XB_SPIN(cond, bar) do { unsigned _sp = 0; while (cond) { __builtin_amdgcn_s_sleep(1); \
    if ((++_sp & 255u) == 0u) { if (xb_ld(&(bar)[XB_TMO])) break; if (_sp > XB_SPIN_CAP) { atomicAdd(&(bar)[XB_TMO], 1u); break; } } } } while (0)

struct XcdBarrier {
    unsigned* bar; unsigned x;
    volatile LAS unsigned* st;
};

__device__ __forceinline__ XcdBarrier xcd_barrier_post(unsigned* bar, volatile LAS unsigned* st) {
    XcdBarrier b; b.bar = bar; b.x = xb_xcc_id(); b.st = st;
    if (threadIdx.x == 0) (void)xb_add(&bar[XB_XCNT(b.x)], 1u);
    return b;
}
__device__ __forceinline__ void xcd_barrier_complete(unsigned* bar, unsigned x, unsigned& nloc, unsigned& nx) {
    const unsigned G = gridDim.x * gridDim.y * gridDim.z;
    unsigned sum, cnt, mine, sp = 0u;
    for (;;) {
        sum = 0u; cnt = 0u; mine = 0u;
#pragma unroll
        for (unsigned j = 0; j < 16; ++j) { const unsigned c = xb_ld(&bar[XB_XCNT(j)]); sum += c; cnt += (c > 0u) ? 1u : 0u; mine = (j == x) ? c : mine; }
        if (sum == G) break;
        __builtin_amdgcn_s_sleep(1);
        if ((++sp & 255u) == 0u) { if (xb_ld(&bar[XB_TMO])) break; if (sp > XB_SPIN_CAP) { atomicAdd(&bar[XB_TMO], 1u); break; } }
    }
    nloc = mine > 0u ? mine : 1u; nx = cnt > 0u ? cnt : 1u;
}

__device__ __forceinline__ void xcd_barrier(const XcdBarrier& b) {
    asm volatile("s_waitcnt vmcnt(0)" ::: "memory");
    __syncthreads();
    if (threadIdx.x == 0) {
        unsigned* bar = b.bar;
        __builtin_amdgcn_s_waitcnt(0);
        unsigned nloc = b.st[0], nx = b.st[1];
        if (nloc == 0u) { xcd_barrier_complete(bar, b.x, nloc, nx); b.st[0] = nloc; b.st[1] = nx; }
        const unsigned old = xb_add(&bar[XB_XSUB(b.x)], 1u);
        const unsigned gen = old / nloc;
        if (old + 1u == (gen + 1u) * nloc) {
            __builtin_amdgcn_fence(__ATOMIC_RELEASE, "agent");
            asm volatile("s_waitcnt vmcnt(0)" ::: "memory");
            const unsigned og = xb_add(&bar[XB_TOP], 1u);
            const unsigned tg = og / nx;
            if (og + 1u == (tg + 1u) * nx) xb_add(&bar[XB_TOPGEN], 1u);
            else XB_SPIN(xb_ld(&bar[XB_TOPGEN]) == tg, bar);
            __builtin_amdgcn_fence(__ATOMIC_ACQUIRE, "agent");
            xb_add(&bar[XB_XGEN(b.x)], 1u);
            asm volatile("s_waitcnt vmcnt(0)" ::: "memory");
        } else {
            XB_SPIN(xb_ld(&bar[XB_XGEN(b.x)]) == gen, bar);
            __builtin_amdgcn_fence(__ATOMIC_ACQUIRE, "agent");
            asm volatile("s_waitcnt vmcnt(0)" ::: "memory");
        }
    }
    __syncthreads();
}

__device__ __forceinline__ void run_program_phase(const Params& p, int ph, char* smem) {
  if (ph == 0) { run_phase<PH_PREP>(p, 0, 0, smem); return; }
  if (ph == 37) { run_phase<PH_ROW>(p, DEPTH, 0, smem); return; }
  const int layer = (ph - 1) / 9, k = (ph - 1) % 9;
  switch (k) {
    case 0: run_phase<PH_ROW>(p, layer, 0, smem); break;
    case 1: run_phase<PH_INPROJ>(p, layer, 0, smem); break;
    case 2: run_phase<PH_M1>(p, layer, 0, smem); break;
    case 3: run_phase<PH_M2>(p, layer, 0, smem); break;
    case 4: run_phase<PH_G3>(p, layer, 0, smem); break;
    case 5: run_phase<PH_OUTPROJ>(p, layer, 0, smem); break;
    case 6: run_phase<PH_ROW>(p, layer, 1, smem); break;
    case 7: run_phase<PH_FFNUP>(p, layer, 0, smem); break;
    default: run_phase<PH_FFNDOWN>(p, layer, 0, smem); break;
  }
}
__global__ void __launch_bounds__(256, 2) k_mega(Params p, int ph_lo, int ph_hi, int bar_slot) {
  __shared__ __attribute__((aligned(16))) char smem[SMEM_BYTES];
#if COOP
  if (ph_lo < 0) cg::this_grid().sync();
#endif
  unsigned nbar = 0;
  unsigned* bar = p.BAR + bar_slot * 64;
  (void)nbar; (void)bar;
  volatile LAS unsigned* xst = (volatile LAS unsigned*)(smem + SMEM_BYTES - 16);
  if (threadIdx.x == 0) { xst[0] = 0u; xst[1] = 0u; }
  __syncthreads();
  XcdBarrier xb = xcd_barrier_post(p.BAR, xst);
#pragma unroll 1
  for (int ph = ph_lo; ph < ph_hi; ++ph) {
    run_program_phase(p, ph, smem);
#ifdef REPEAT_MASK
    if (ph >= 1 && ph < 37 && ((REPEAT_MASK >> ((ph - 1) % 9)) & 1)) { ++nbar; grid_barrier(bar, nbar * gridDim.x); run_program_phase(p, ph, smem); }
#endif
    if (ph + 1 < ph_hi) xcd_barrier(xb);
#ifdef DOUBLE_BAR
    if (ph + 1 < ph_hi) xcd_barrier(xb);
#endif
  }
}

extern "C" void kernel_launch(void* const* d_in, const int* in_sizes, int n_in, void* d_out, int out_size, void* d_ws, size_t ws_size, hipStream_t stream) {
  Params p{};
  p.x = (const float*)d_in[0]; p.c = (const float*)d_in[1]; p.ctx = (const float*)d_in[2]; p.c_ctx = (const float*)d_in[3];
  p.w_ada = (const float*)d_in[4]; p.b_ada = (const float*)d_in[5]; p.w_in = (const float*)d_in[6]; p.w_gg = (const float*)d_in[7]; p.b_gg = (const float*)d_in[8];
  p.gla_g = (const float*)d_in[9]; p.dlam = (const float*)d_in[10]; p.diff_g = (const float*)d_in[11]; p.sink = (const float*)d_in[12]; p.w_out = (const float*)d_in[13];
  p.ln_g = (const float*)d_in[14]; p.ln_b = (const float*)d_in[15]; p.w_fg = (const float*)d_in[16]; p.w_fu = (const float*)d_in[17]; p.w_fd = (const float*)d_in[18];
  p.out = (float*)d_out;
  char* ws = (char*)d_ws; size_t off = 0;
  auto take = [&](size_t bytes) { char* r = ws + off; off += (bytes + 255) & ~(size_t)255; return r; };
  p.Z = (float*)take((size_t)TTOK * DM * 4);
  p.MIX = (bf16*)take((size_t)TTOK * DM * 2);
  p.P = (bf16*)take((size_t)TTOK * PW * 2);
  p.HID = p.MIX;
  p.GVt = (bf16*)take((size_t)NBATCH * 256 * TPB * 2);
  p.DVt = (bf16*)take((size_t)NBATCH * 256 * TPB * 2);
  p.SVt = (bf16*)take((size_t)NBATCH * 128 * TPB * 2);
  p.GZ = (float*)take((size_t)TTOK * 32 * 4);
  p.U = (bf16*)take((size_t)TTOK * DM * 2);
  p.SlocT = (float*)p.U;
  p.Sprev = (bf16*)take((size_t)64 * NCHUNK * 4096 * 2);
  p.MOD = (float*)take((size_t)DEPTH * 9 * 6144 * 4);
  p.ST = (float*)take((size_t)TTOK * 2 * 4);
  p.DEC = (float*)take((size_t)64 * NCHUNK * 64 * 4);
  p.TAB32 = (float*)take(64 * 8 * 2 * 4);
  p.TAB64 = (float*)take(64 * 16 * 2 * 4);
  p.LAM = (float*)take(256);
  p.BAR = (unsigned*)take(16384);
  if (off > ws_size) { fprintf(stderr, "workspace too small: need %zu have %zu\n", off, ws_size); return; }
  { char* o = (char*)d_out; size_t oo = 0;
    p.WinT = (bf16*)(o + oo); oo += (size_t)DEPTH * WIN_ROWS * DM * 2;
    p.WoT = (bf16*)(o + oo); oo += (size_t)DEPTH * DM * DM * 2;
    p.WguT = (bf16*)(o + oo); oo += (size_t)DEPTH * 5632 * DM * 2;
    p.WdT = (bf16*)(o + oo); oo += (size_t)DEPTH * DM * FFNH * 2; }
#if MEGA
  static int grid_blocks = 0;
  if (!grid_blocks) { int dev = 0, cus = 0, per_cu = 0; (void)hipGetDevice(&dev); (void)hipDeviceGetAttribute(&cus, hipDeviceAttributeMultiprocessorCount, dev);
    (void)hipOccupancyMaxActiveBlocksPerMultiprocessor(&per_cu, k_mega, 256, 0); if (per_cu > 2) per_cu = 2; if (per_cu < 1) per_cu = 1; grid_blocks = (cus * per_cu) & ~7; if (grid_blocks < 8) grid_blocks = 8; }
  (void)hipMemsetAsync(p.BAR, 0, 16384, stream);
  int cuts[48]; int ncut = 0; cuts[ncut++] = 0;
  if (!((FUSE >> 9) & 1)) cuts[ncut++] = 1;
  for (int ph = 1; ph < 37; ++ph) { const int k = (ph - 1) % 9; if (!((FUSE >> k) & 1)) cuts[ncut++] = ph + 1; }
  cuts[ncut++] = 38;
  for (int i = 0; i + 1 < ncut; ++i) if (cuts[i + 1] > cuts[i]) {
#if COOP
    int lo = cuts[i], hi = cuts[i + 1], slot = i; void* args[] = {&p, &lo, &hi, &slot};
    hipError_t e = hipLaunchCooperativeKernel((void*)k_mega, dim3(grid_blocks), dim3(256), args, 0, stream);
    if (e != hipSuccess) fprintf(stderr, "cooperative launch failed: %s (grid %d)\n", hipGetErrorString(e), grid_blocks);
#else
    k_mega<<<grid_blocks, 256, 0, stream>>>(p, cuts[i], cuts[i + 1], i);
#endif
  }
#else
  const int G = 2048;
  k_phase<PH_PREP><<<G, 256, 0, stream>>>(p, 0, 0);
  for (int layer = 0; layer < DEPTH; ++layer) {
    k_phase<PH_ROW><<<G, 256, 0, stream>>>(p, layer, 0);
    k_phase<PH_INPROJ><<<G, 256, 0, stream>>>(p, layer, 0);
    k_phase<PH_M1><<<G, 256, 0, stream>>>(p, layer, 0);
    k_phase<PH_M2><<<G, 256, 0, stream>>>(p, layer, 0);
    k_phase<PH_G3><<<G, 256, 0, stream>>>(p, layer, 0);
    k_phase<PH_OUTPROJ><<<G, 256, 0, stream>>>(p, layer, 0);
    k_phase<PH_ROW><<<G, 256, 0, stream>>>(p, layer, 1);
    k_phase<PH_FFNUP><<<G, 256, 0, stream>>>(p, layer, 0);
    k_phase<PH_FFNDOWN><<<G, 256, 0, stream>>>(p, layer, 0);
  }
  k_phase<PH_ROW><<<G, 256, 0, stream>>>(p, DEPTH, 0);
#endif
}
```
